# Optimizing an MI355X kernel written in HIP

```python
import math
import jax, jax.numpy as jnp
from jax import lax
import numpy as np

D_MODEL = 2048
BATCH = 4
SEQ = 2048
DEPTH = 2

HEAD_DIM = 128
MIX_WIDTH = D_MODEL
N_HEADS_DIFF = MIX_WIDTH // 2 // HEAD_DIM
DIFF_QK_DIM = HEAD_DIM // 2
N_HEADS_SWA = MIX_WIDTH // 2 // HEAD_DIM
N_KV_SWA = N_HEADS_SWA // 4
WINDOW = 128
BLOCK = 128
D_FF = 4 * D_MODEL
ROPE_THETA = 10000.0
EPS = 1e-6
N_MOD = 6

DIFF_W = N_HEADS_DIFF * HEAD_DIM
SWA_Q_W = N_HEADS_SWA * HEAD_DIM
SWA_KV_W = N_KV_SWA * HEAD_DIM
IN_WIDTH = 3 * DIFF_W + SWA_Q_W + 2 * SWA_KV_W

kernel_name = "hymba_style_diffattn_swa_encoder"


def rmsnorm(x, g):
    xf = x.astype(jnp.float32)
    y = xf * lax.rsqrt(jnp.mean(xf * xf, axis=-1, keepdims=True) + EPS)
    return y.astype(x.dtype) * g


def rope_tables(positions, dim):
    inv = ROPE_THETA ** (-jnp.arange(0, dim, 2, dtype=jnp.float32) / dim)
    ang = positions.astype(jnp.float32)[..., None] * inv
    return jnp.cos(ang), jnp.sin(ang)


def apply_rope(x, cos, sin):
    shp = cos.shape[:2] + (1,) * (x.ndim - 3) + cos.shape[-1:]
    cos = cos.reshape(shp).astype(x.dtype)
    sin = sin.reshape(shp).astype(x.dtype)
    x1, x2 = jnp.split(x, 2, axis=-1)
    return jnp.concatenate([x1 * cos - x2 * sin, x2 * cos + x1 * sin], axis=-1)


def diff_attention(q, k, v, lam, lam_init, subln_g, cos, sin):
    b, s, h = q.shape[:3]
    nb = s // BLOCK
    q = apply_rope(q, cos, sin) * (DIFF_QK_DIM ** -0.5)
    k = apply_rope(k, cos, sin)
    qb = jnp.moveaxis(q.reshape(b, nb, BLOCK, h, 2, DIFF_QK_DIM), 1, 0)

    def one_block(qblk):
        logits = jnp.einsum('bqhmd,bkhmd->bhmqk', qblk, k).astype(jnp.float32)
        p = jax.nn.softmax(logits, axis=-1)
        w = (p[:, :, 0] - lam * p[:, :, 1]).astype(v.dtype)
        return jnp.einsum('bhqk,bkhd->bqhd', w, v)

    o = lax.map(one_block, qb)
    o = jnp.moveaxis(o, 0, 1).reshape(b, s, h, HEAD_DIM)
    o = rmsnorm(o, subln_g) * (1.0 - lam_init)
    return o.reshape(b, s, h * HEAD_DIM)


def window_gqa_sink(q, k, v, sink, cos, sin):
    b, s, h, d = q.shape
    g = k.shape[2]
    r = h // g
    nb = s // BLOCK
    q = apply_rope(q, cos, sin) * (d ** -0.5)
    k = apply_rope(k, cos, sin)
    qb = q.reshape(b, nb, BLOCK, g, r, d)

    def band(t):
        tp = jnp.pad(t, ((0, 0), (BLOCK, BLOCK), (0, 0), (0, 0))).reshape(b, nb + 2, BLOCK, g, d)
        return jnp.concatenate([tp[:, :-2], tp[:, 1:-1], tp[:, 2:]], axis=2)

    kb, vb = band(k), band(v)
    qi = jnp.arange(BLOCK)[:, None]
    kj = jnp.arange(3 * BLOCK)[None, :]
    rel = kj - BLOCK - qi
    kpos = jnp.arange(nb)[:, None, None] * BLOCK + kj[None] - BLOCK
    mask = (jnp.abs(rel)[None] <= WINDOW) & (kpos >= 0) & (kpos < s)

    logits = jnp.einsum('bnqgrd,bnkgd->bngrqk', qb, kb).astype(jnp.float32)
    logits = jnp.where(mask[None, :, None, None], logits, -jnp.inf)
    sink_l = sink.astype(jnp.float32).reshape(1, 1, g, r, 1, 1)
    m = jnp.maximum(logits.max(axis=-1, keepdims=True), sink_l)
    e = jnp.exp(logits - m)
    p = e / (e.sum(axis=-1, keepdims=True) + jnp.exp(sink_l - m))
    o = jnp.einsum('bngrqk,bnkgd->bnqgrd', p.astype(v.dtype), vb)
    return o.reshape(b, s, h * d)


def setup_inputs(seed: int = 0) -> dict:
    key = jax.random.key(seed)
    ks = jax.random.split(key, 16)
    nrm = jax.random.normal
    x = nrm(ks[0], (BATCH, SEQ, D_MODEL), jnp.float32)
    c = nrm(ks[1], (BATCH, D_MODEL), jnp.float32)
    offsets = jax.random.randint(ks[2], (BATCH, 1), 0, SEQ, dtype=jnp.int32)
    positions = (offsets + jnp.arange(SEQ, dtype=jnp.int32)[None, :]).astype(jnp.int32)
    ada_w = nrm(ks[3], (DEPTH, D_MODEL, N_MOD * D_MODEL), jnp.float32) * (0.5 * D_MODEL ** -0.5)
    ada_b = nrm(ks[4], (DEPTH, N_MOD * D_MODEL), jnp.float32) * 0.1
    norm_mix = 1.0 + 0.05 * nrm(ks[5], (DEPTH, D_MODEL), jnp.float32)
    w_in = nrm(ks[6], (DEPTH, D_MODEL, IN_WIDTH), jnp.float32) * (D_MODEL ** -0.5)
    diff_lambda = nrm(ks[7], (DEPTH, 4, DIFF_QK_DIM), jnp.float32) * 0.1
    diff_subln = 1.0 + 0.05 * nrm(ks[8], (DEPTH, HEAD_DIM), jnp.float32)
    swa_sink = nrm(ks[9], (DEPTH, N_HEADS_SWA), jnp.float32)
    w_out = nrm(ks[10], (DEPTH, MIX_WIDTH, D_MODEL), jnp.float32) * (MIX_WIDTH ** -0.5)
    norm_mlp = 1.0 + 0.05 * nrm(ks[11], (DEPTH, D_MODEL), jnp.float32)
    w_up = nrm(ks[12], (DEPTH, D_MODEL, D_FF), jnp.float32) * (D_MODEL ** -0.5)
    w_down = nrm(ks[13], (DEPTH, D_FF, D_MODEL), jnp.float32) * (D_FF ** -0.5)
    final_norm = 1.0 + 0.05 * nrm(ks[14], (D_MODEL,), jnp.float32)
    return {"x": x, "c": c, "positions": positions, "ada_w": ada_w, "ada_b": ada_b,
            "norm_mix": norm_mix, "w_in": w_in, "diff_lambda": diff_lambda,
            "diff_subln": diff_subln, "swa_sink": swa_sink, "w_out": w_out,
            "norm_mlp": norm_mlp, "w_up": w_up, "w_down": w_down, "final_norm": final_norm}


def reference(x, c, positions, ada_w, ada_b, norm_mix, w_in, diff_lambda, diff_subln,
              swa_sink, w_out, norm_mlp, w_up, w_down, final_norm):
    b, s, _ = x.shape
    cos_a, sin_a = rope_tables(positions, DIFF_QK_DIM)
    cos_b, sin_b = rope_tables(positions, HEAD_DIM)
    c_act = jax.nn.silu(c)
    splits = np.cumsum([DIFF_W, DIFF_W, DIFF_W, SWA_Q_W, SWA_KV_W]).tolist()

    for layer in range(DEPTH):
        mod = c_act @ ada_w[layer] + ada_b[layer]
        sh1, sc1, g1, sh2, sc2, g2 = [t[:, None, :] for t in jnp.split(mod, N_MOD, axis=-1)]

        h = rmsnorm(x, norm_mix[layer]) * (1.0 + sc1) + sh1
        proj = h @ w_in[layer]
        qa, ka, va, qb, kb, vb = jnp.split(proj, splits, axis=-1)
        qa = qa.reshape(b, s, N_HEADS_DIFF, 2, DIFF_QK_DIM)
        ka = ka.reshape(b, s, N_HEADS_DIFF, 2, DIFF_QK_DIM)
        va = va.reshape(b, s, N_HEADS_DIFF, HEAD_DIM)
        lam_init = 0.8 - 0.6 * math.exp(-0.3 * layer)
        lp = diff_lambda[layer].astype(jnp.float32)
        lam = jnp.exp(jnp.sum(lp[0] * lp[1])) - jnp.exp(jnp.sum(lp[2] * lp[3])) + lam_init
        out_a = diff_attention(qa, ka, va, lam, lam_init, diff_subln[layer], cos_a, sin_a)

        qb = qb.reshape(b, s, N_HEADS_SWA, HEAD_DIM)
        kb = kb.reshape(b, s, N_KV_SWA, HEAD_DIM)
        vb = vb.reshape(b, s, N_KV_SWA, HEAD_DIM)
        out_b = window_gqa_sink(qb, kb, vb, swa_sink[layer], cos_b, sin_b)

        mixed = jnp.concatenate([out_a, out_b], axis=-1) @ w_out[layer]
        x = x + g1 * mixed

        h2 = rmsnorm(x, norm_mlp[layer]) * (1.0 + sc2) + sh2
        x = x + g2 * (jnp.square(jax.nn.relu(h2 @ w_up[layer])) @ w_down[layer])

    return rmsnorm(x, final_norm)
```

```cpp
#include <hip/hip_runtime.h>
#include <cstdio>
#include <cstdint>

constexpr int NB = 4, SEQ = 2048, DM = 2048, NT = NB * SEQ, DEPTH = 2, NPROJ = 4608, FF = 8192, NMOD = 6;
constexpr int HD = 128;
constexpr float EPS = 1e-6f;

typedef unsigned short bf16;
typedef short bf16x8 __attribute__((ext_vector_type(8)));
typedef float f32x4 __attribute__((ext_vector_type(4)));

__device__ __forceinline__ unsigned f2bf(float f) { unsigned u = __builtin_bit_cast(unsigned, f); return (u + 0x7fffu + ((u >> 16) & 1u)) >> 16; }
__device__ __forceinline__ float bf2f(bf16 h) { return __builtin_bit_cast(float, (unsigned)h << 16); }

constexpr size_t MiB = 1u << 20;
constexpr size_t WS_MOD = 1 * MiB;
constexpr size_t WS_ROPEA = 2 * MiB;
constexpr size_t WS_ROPEB = WS_ROPEA + (size_t)NT * 32 * 2 * 4;
constexpr size_t WS_WIN = 10 * MiB;
constexpr size_t WS_WOUT = WS_WIN + (size_t)DEPTH * NPROJ * DM * 2;
constexpr size_t WS_WUP = WS_WOUT + (size_t)DEPTH * DM * DM * 2;
constexpr size_t WS_WDN = WS_WUP + (size_t)DEPTH * FF * DM * 2;
constexpr size_t WS_X = WS_WDN + (size_t)DEPTH * DM * FF * 2;
constexpr size_t WS_H = WS_X + (size_t)NT * DM * 4;
constexpr size_t WS_PROJ = WS_H + (size_t)NT * DM * 2;
constexpr size_t WS_ATT = WS_PROJ + (size_t)NT * NPROJ * 2;
constexpr size_t WS_U = WS_ATT + (size_t)NT * DM * 2;
constexpr size_t WS_P32 = WS_U + (size_t)NT * FF * 2;
constexpr size_t WS_END = WS_P32 + (size_t)NT * NPROJ * 4;

__global__ void k_rope_tab(const int* __restrict__ pos, float* __restrict__ ra, float* __restrict__ rb) {
    int idx = blockIdx.x * blockDim.x + threadIdx.x;
    if (idx >= NT * 96) return;
    int t = idx / 96, j = idx % 96;
    int dim = j < 32 ? 64 : 128, i = j < 32 ? j : j - 32;
    float inv = (float)pow(10000.0, -(double)(2 * i) / (double)dim);
    float ang = (float)pos[t] * inv;
    double sn, cs; sincos((double)ang, &sn, &cs);
    float* dst = j < 32 ? ra + ((size_t)t * 32 + i) * 2 : rb + ((size_t)t * 64 + i) * 2;
    dst[0] = (float)cs; dst[1] = (float)sn;
}

__global__ void k_mod(const float* __restrict__ c, const float* __restrict__ ada_w, const float* __restrict__ ada_b, float* __restrict__ mod) {
    __shared__ float cact[NB][DM];
    __shared__ float red[4][NB][64];
    const int tid = threadIdx.x;
    for (int i = tid; i < NB * DM; i += 256) { float v = c[i]; cact[i / DM][i % DM] = v / (1.f + __expf(-v)); }
    __syncthreads();
    const int NJ = NMOD * DM;
    const int col = blockIdx.x * 64 + (tid & 63), kg = tid >> 6;
    const int l = col / NJ, j = col % NJ;
    const float* w = ada_w + (size_t)l * DM * NJ + j;
    float a0 = 0, a1 = 0, a2 = 0, a3 = 0;
    for (int k = kg * 512; k < kg * 512 + 512; ++k) { float wv = w[(size_t)k * NJ]; a0 += cact[0][k] * wv; a1 += cact[1][k] * wv; a2 += cact[2][k] * wv; a3 += cact[3][k] * wv; }
    red[kg][0][tid & 63] = a0; red[kg][1][tid & 63] = a1; red[kg][2][tid & 63] = a2; red[kg][3][tid & 63] = a3;
    __syncthreads();
    if (kg == 0) {
        for (int b = 0; b < NB; ++b) { float s = red[0][b][tid] + red[1][b][tid] + red[2][b][tid] + red[3][b][tid] + ada_b[(size_t)l * NJ + j];
            mod[((size_t)l * NB + b) * NJ + j] = s; }
    }
}

__global__ void k_wt(const float* __restrict__ W, bf16* __restrict__ Wt, int K, int N) {
    __shared__ float tile[32][33];
    const int n0 = blockIdx.x * 32, k0 = blockIdx.y * 32, tx = threadIdx.x & 31, ty = threadIdx.x >> 5;
    for (int i = ty; i < 32; i += 8) tile[i][tx] = W[(size_t)(k0 + i) * N + n0 + tx];
    __syncthreads();
    for (int i = ty; i < 32; i += 8) Wt[(size_t)(n0 + i) * K + k0 + tx] = (bf16)f2bf(tile[tx][i]);
}

__global__ void k_norm_mod(const float* __restrict__ x, const float* __restrict__ g, const float* __restrict__ sh, const float* __restrict__ sc, bf16* __restrict__ h) {
    __shared__ float red[4];
    const int t = blockIdx.x, b = t / SEQ, tid = threadIdx.x;
    const float* xr = x + (size_t)t * DM;
    float v[8]; float s = 0;
    for (int i = 0; i < 8; ++i) { v[i] = xr[tid + 256 * i]; s += v[i] * v[i]; }
    for (int o = 32; o > 0; o >>= 1) s += __shfl_xor(s, o);
    if ((tid & 63) == 0) red[tid >> 6] = s;
    __syncthreads();
    s = red[0] + red[1] + red[2] + red[3];
    const float rstd = rsqrtf(s * (1.f / DM) + EPS);
    for (int i = 0; i < 8; ++i) { int cidx = tid + 256 * i; float y = v[i] * rstd * g[cidx];
        y = y * (1.f + sc[(size_t)b * NMOD * DM + cidx]) + sh[(size_t)b * NMOD * DM + cidx];
        h[(size_t)t * DM + cidx] = (bf16)f2bf(y); }
}

__global__ void k_final_norm(const float* __restrict__ x, const float* __restrict__ g, float* __restrict__ out) {
    __shared__ float red[4];
    const int t = blockIdx.x, tid = threadIdx.x;
    const float* xr = x + (size_t)t * DM;
    float v[8]; float s = 0;
    for (int i = 0; i < 8; ++i) { v[i] = xr[tid + 256 * i]; s += v[i] * v[i]; }
    for (int o = 32; o > 0; o >>= 1) s += __shfl_xor(s, o);
    if ((tid & 63) == 0) red[tid >> 6] = s;
    __syncthreads();
    s = red[0] + red[1] + red[2] + red[3];
    const float rstd = rsqrtf(s * (1.f / DM) + EPS);
    for (int i = 0; i < 8; ++i) { int cidx = tid + 256 * i; out[(size_t)t * DM + cidx] = v[i] * rstd * g[cidx]; }
}

struct EpiF32 { float* C; int ldc; int pad; __device__ void operator()(int m, int n, float v) const { C[(size_t)m * ldc + n] = v; } };
struct EpiResGate { const float* xin; float* xout; const float* gate;   __device__ void operator()(int m, int n, float v) const {
    const int b = m / SEQ; xout[(size_t)m * DM + n] = xin[(size_t)m * DM + n] + gate[(size_t)b * NMOD * DM + n] * v; } };
struct EpiRelu2 { bf16* U; __device__ void operator()(int m, int n, float v) const { float r = v > 0.f ? v : 0.f; U[(size_t)m * FF + n] = (bf16)f2bf(r * r); } };

template <class Epi>
__global__ void __launch_bounds__(256) k_gemm(const bf16* __restrict__ A, const bf16* __restrict__ Bt, int M, int N, int K, int pad_, Epi epi) {
    const int lane = threadIdx.x & 63, w = threadIdx.x >> 6;
    const int m0 = blockIdx.y * 64 + w * 16, n0 = blockIdx.x * 64;
    const int fr = lane & 15, fq = lane >> 4;
    f32x4 acc[4] = {};
    const bf16* ap = A + (size_t)(m0 + fr) * K + fq * 8;
    const bf16* bp = Bt + (size_t)(n0 + fr) * K + fq * 8;
    for (int k0 = 0; k0 < K; k0 += 32) {
        bf16x8 a = *(const bf16x8*)(ap + k0);
#pragma unroll
        for (int nb = 0; nb < 4; ++nb) { bf16x8 b = *(const bf16x8*)(bp + (size_t)nb * 16 * K + k0);
            acc[nb] = __builtin_amdgcn_mfma_f32_16x16x32_bf16(a, b, acc[nb], 0, 0, 0); }
    }
#pragma unroll
    for (int nb = 0; nb < 4; ++nb)
#pragma unroll
        for (int j = 0; j < 4; ++j) epi(m0 + fq * 4 + j, n0 + nb * 16 + fr, acc[nb][j]);
}

__global__ void k_rope_apply(const float* __restrict__ p32, const float* __restrict__ ra, const float* __restrict__ rb, bf16* __restrict__ proj) {
    const int t = blockIdx.x;
    const float* src = p32 + (size_t)t * NPROJ; bf16* dst = proj + (size_t)t * NPROJ;
    for (int cidx = threadIdx.x; cidx < NPROJ; cidx += 256) {
        float v = src[cidx], o;
        bool ropeA = cidx < 2048, ropeB = (cidx >= 3072 && cidx < 4352);
        if (ropeA) { int d = cidx & 63, i = d & 31; const float* cs = ra + ((size_t)t * 32 + i) * 2;
            float other = src[(cidx & ~63) + ((d + 32) & 63)];
            o = d < 32 ? v * cs[0] - other * cs[1] : v * cs[0] + other * cs[1]; }
        else if (ropeB) { int d = cidx & 127, i = d & 63; const float* cs = rb + ((size_t)t * 64 + i) * 2;
            float other = src[(cidx & ~127) + ((d + 64) & 127)];
            o = d < 64 ? v * cs[0] - other * cs[1] : v * cs[0] + other * cs[1]; }
        else o = v;
        dst[cidx] = (bf16)f2bf(o);
    }
}

__global__ void __launch_bounds__(256) k_diff_attn(const bf16* __restrict__ proj, const float* __restrict__ lam_p  , const float* __restrict__ subln, bf16* __restrict__ att, float lam_init, int pad_) {
    extern __shared__ float sm[];
    const int lane = threadIdx.x & 63, w = threadIdx.x >> 6;
    float* q = sm + w * (128 + 2 * SEQ);
    float* l1 = q + 128; float* l2 = l1 + SEQ;
    const int gid = blockIdx.x * 4 + w;
    const int s = gid % SEQ, h = (gid / SEQ) % 8, b = gid / (SEQ * 8);
    const size_t trow = (size_t)b * SEQ + s;
    float p01 = lam_p[lane] * lam_p[64 + lane], p23 = lam_p[128 + lane] * lam_p[192 + lane];
    for (int o = 32; o > 0; o >>= 1) { p01 += __shfl_xor(p01, o); p23 += __shfl_xor(p23, o); }
    const float lam = __expf(p01) - __expf(p23) + lam_init;
    const bf16* qp = proj + trow * NPROJ + h * 128;
    q[lane] = bf2f(qp[lane]) * 0.125f; q[64 + lane] = bf2f(qp[64 + lane]) * 0.125f;
    __syncthreads();
    float m1 = -1e30f, m2 = -1e30f;
    for (int j = lane; j < SEQ; j += 64) {
        const bf16* kp = proj + ((size_t)b * SEQ + j) * NPROJ + 1024 + h * 128;
        float d1 = 0, d2 = 0;
        for (int d = 0; d < 64; d += 8) { bf16x8 k1 = *(const bf16x8*)(kp + d), k2 = *(const bf16x8*)(kp + 64 + d);
            for (int e = 0; e < 8; ++e) { d1 += q[d + e] * bf2f((bf16)k1[e]); d2 += q[64 + d + e] * bf2f((bf16)k2[e]); } }
        l1[j] = d1; l2[j] = d2; m1 = fmaxf(m1, d1); m2 = fmaxf(m2, d2);
    }
    for (int o = 32; o > 0; o >>= 1) { m1 = fmaxf(m1, __shfl_xor(m1, o)); m2 = fmaxf(m2, __shfl_xor(m2, o)); }
    float s1 = 0, s2 = 0;
    for (int j = lane; j < SEQ; j += 64) { float e1 = __expf(l1[j] - m1), e2 = __expf(l2[j] - m2); l1[j] = e1; l2[j] = e2; s1 += e1; s2 += e2; }
    for (int o = 32; o > 0; o >>= 1) { s1 += __shfl_xor(s1, o); s2 += __shfl_xor(s2, o); }
    const float i1 = 1.f / s1, i2 = lam / s2;
    for (int j = lane; j < SEQ; j += 64) l1[j] = l1[j] * i1 - l2[j] * i2;
    __syncthreads();
    float o0 = 0, o1 = 0;
    const bf16* vp = proj + (size_t)b * SEQ * NPROJ + 2048 + h * 128;
    for (int j = 0; j < SEQ; ++j) { float wj = l1[j]; o0 += wj * bf2f(vp[(size_t)j * NPROJ + lane]); o1 += wj * bf2f(vp[(size_t)j * NPROJ + 64 + lane]); }
    float ss = o0 * o0 + o1 * o1;
    for (int o = 32; o > 0; o >>= 1) ss += __shfl_xor(ss, o);
    const float r = rsqrtf(ss * (1.f / 128.f) + EPS) * (1.f - lam_init);
    att[trow * DM + h * 128 + lane] = (bf16)f2bf(o0 * r * subln[lane]);
    att[trow * DM + h * 128 + 64 + lane] = (bf16)f2bf(o1 * r * subln[64 + lane]);
}

__global__ void __launch_bounds__(256) k_swa(const bf16* __restrict__ proj, const float* __restrict__ sink, bf16* __restrict__ att) {
    __shared__ float sm[4][128 + 320];
    const int lane = threadIdx.x & 63, w = threadIdx.x >> 6;
    float* q = sm[w]; float* p = q + 128;
    const int gid = blockIdx.x * 4 + w;
    const int s = gid % SEQ, h = (gid / SEQ) % 8, b = gid / (SEQ * 8), g = h / 4;
    const size_t trow = (size_t)b * SEQ + s;
    const bf16* qp = proj + trow * NPROJ + 3072 + h * 128;
    const float scale = 0.08838834764831845f;
    q[lane] = bf2f(qp[lane]) * scale; q[64 + lane] = bf2f(qp[64 + lane]) * scale;
    __syncthreads();
    const int j0 = s - 128;
    float lg[5]; float m = sink[h];
    for (int r = 0; r < 5; ++r) { int jj = lane + 64 * r, j = j0 + jj; lg[r] = -1e30f;
        if (jj <= 256 && j >= 0 && j < SEQ) { const bf16* kp = proj + ((size_t)b * SEQ + j) * NPROJ + 4096 + g * 128; float d = 0;
            for (int dd = 0; dd < 128; dd += 8) { bf16x8 kv = *(const bf16x8*)(kp + dd); for (int e = 0; e < 8; ++e) d += q[dd + e] * bf2f((bf16)kv[e]); }
            lg[r] = d; }
        m = fmaxf(m, lg[r]); }
    for (int o = 32; o > 0; o >>= 1) m = fmaxf(m, __shfl_xor(m, o));
    float sum = 0;
    for (int r = 0; r < 5; ++r) { float e = lg[r] > -1e29f ? __expf(lg[r] - m) : 0.f; p[lane + 64 * r] = e; sum += e; }
    for (int o = 32; o > 0; o >>= 1) sum += __shfl_xor(sum, o);
    sum += __expf(sink[h] - m);
    const float inv = 1.f / sum;
    __syncthreads();
    float o0 = 0, o1 = 0;
    const bf16* vp = proj + (size_t)b * SEQ * NPROJ + 4352 + g * 128;
    for (int jj = 0; jj <= 256; ++jj) { int j = j0 + jj; if (j < 0 || j >= SEQ) continue; float pj = p[jj];
        o0 += pj * bf2f(vp[(size_t)j * NPROJ + lane]); o1 += pj * bf2f(vp[(size_t)j * NPROJ + 64 + lane]); }
    att[trow * DM + 1024 + h * 128 + lane] = (bf16)f2bf(o0 * inv);
    att[trow * DM + 1024 + h * 128 + 64 + lane] = (bf16)f2bf(o1 * inv);
}

extern "C" void kernel_launch(void* const* d_in, const int* in_sizes, int n_in, void* d_out, int out_size, void* d_ws, size_t ws_size, hipStream_t stream) {
    if (n_in != 15 || out_size != NT * DM || ws_size < WS_END) { fprintf(stderr, "kernel_launch: unexpected shapes n_in %d out %d ws %zu (need %zu)\n", n_in, out_size, ws_size, (size_t)WS_END); return; }
    const float* x = (const float*)d_in[0]; const float* c = (const float*)d_in[1]; const int* pos = (const int*)d_in[2];
    const float* ada_w = (const float*)d_in[3]; const float* ada_b = (const float*)d_in[4]; const float* norm_mix = (const float*)d_in[5];
    const float* w_in = (const float*)d_in[6]; const float* diff_lambda = (const float*)d_in[7]; const float* diff_subln = (const float*)d_in[8];
    const float* swa_sink = (const float*)d_in[9]; const float* w_out = (const float*)d_in[10]; const float* norm_mlp = (const float*)d_in[11];
    const float* w_up = (const float*)d_in[12]; const float* w_down = (const float*)d_in[13]; const float* final_norm = (const float*)d_in[14];
    char* ws = (char*)d_ws;
    float* mod = (float*)(ws + WS_MOD); float* ra = (float*)(ws + WS_ROPEA); float* rb = (float*)(ws + WS_ROPEB);
    bf16* Win = (bf16*)(ws + WS_WIN); bf16* Wout = (bf16*)(ws + WS_WOUT); bf16* Wup = (bf16*)(ws + WS_WUP); bf16* Wdn = (bf16*)(ws + WS_WDN);
    float* X = (float*)(ws + WS_X); bf16* H = (bf16*)(ws + WS_H); bf16* PROJ = (bf16*)(ws + WS_PROJ); bf16* ATT = (bf16*)(ws + WS_ATT); bf16* U = (bf16*)(ws + WS_U);
    float* P32 = (float*)(ws + WS_P32);

    hipLaunchKernelGGL(k_rope_tab, dim3((NT * 96 + 255) / 256), dim3(256), 0, stream, pos, ra, rb);
    hipLaunchKernelGGL(k_mod, dim3(DEPTH * NMOD * DM / 64), dim3(256), 0, stream, c, ada_w, ada_b, mod);
    for (int l = 0; l < DEPTH; ++l) {
        hipLaunchKernelGGL(k_wt, dim3(NPROJ / 32, DM / 32), dim3(256), 0, stream, w_in + (size_t)l * DM * NPROJ, Win + (size_t)l * NPROJ * DM, DM, NPROJ);
        hipLaunchKernelGGL(k_wt, dim3(DM / 32, DM / 32), dim3(256), 0, stream, w_out + (size_t)l * DM * DM, Wout + (size_t)l * DM * DM, DM, DM);
        hipLaunchKernelGGL(k_wt, dim3(FF / 32, DM / 32), dim3(256), 0, stream, w_up + (size_t)l * DM * FF, Wup + (size_t)l * FF * DM, DM, FF);
        hipLaunchKernelGGL(k_wt, dim3(DM / 32, FF / 32), dim3(256), 0, stream, w_down + (size_t)l * FF * DM, Wdn + (size_t)l * DM * FF, FF, DM);
    }
    const size_t diff_lds = 4 * (128 + 2 * SEQ) * sizeof(float);
    static bool attr_set = false;
    if (!attr_set) { (void)hipFuncSetAttribute((const void*)k_diff_attn, hipFuncAttributeMaxDynamicSharedMemorySize, (int)diff_lds); attr_set = true; }
    for (int l = 0; l < DEPTH; ++l) {
        const float* modl = mod + (size_t)l * NB * NMOD * DM;
        const float* xin = l == 0 ? x : X;
        const float lam_init = 0.8f - 0.6f * expf(-0.3f * (float)l);
        hipLaunchKernelGGL(k_norm_mod, dim3(NT), dim3(256), 0, stream, xin, norm_mix + (size_t)l * DM, modl + 0 * DM, modl + 1 * DM, H);
        hipLaunchKernelGGL(k_gemm<EpiF32>, dim3(NPROJ / 64, NT / 64), dim3(256), 0, stream, (const bf16*)H, (const bf16*)(Win + (size_t)l * NPROJ * DM), NT, NPROJ, DM, 0, EpiF32{P32, NPROJ, 0});
        hipLaunchKernelGGL(k_rope_apply, dim3(NT), dim3(256), 0, stream, (const float*)P32, (const float*)ra, (const float*)rb, PROJ);
        hipLaunchKernelGGL(k_diff_attn, dim3(NB * 8 * SEQ / 4), dim3(256), diff_lds, stream, (const bf16*)PROJ, diff_lambda + (size_t)l * 256, diff_subln + (size_t)l * HD, ATT, lam_init, 0);
        hipLaunchKernelGGL(k_swa, dim3(NB * 8 * SEQ / 4), dim3(256), 0, stream, (const bf16*)PROJ, swa_sink + (size_t)l * 8, ATT);
        hipLaunchKernelGGL(k_gemm<EpiResGate>, dim3(DM / 64, NT / 64), dim3(256), 0, stream, (const bf16*)ATT, (const bf16*)(Wout + (size_t)l * DM * DM), NT, DM, DM, 0, EpiResGate{xin, X, modl + 2 * DM});
        hipLaunchKernelGGL(k_norm_mod, dim3(NT), dim3(256), 0, stream, (const float*)X, norm_mlp + (size_t)l * DM, modl + 3 * DM, modl + 4 * DM, H);
        hipLaunchKernelGGL(k_gemm<EpiRelu2>, dim3(FF / 64, NT / 64), dim3(256), 0, stream, (const bf16*)H, (const bf16*)(Wup + (size_t)l * FF * DM), NT, FF, DM, 0, EpiRelu2{U});
        hipLaunchKernelGGL(k_gemm<EpiResGate>, dim3(DM / 64, NT / 64), dim3(256), 0, stream, (const bf16*)U, (const bf16*)(Wdn + (size_t)l * DM * FF), NT, DM, FF, 0, EpiResGate{(const float*)X, X, modl + 5 * DM});
    }
    hipLaunchKernelGGL(k_final_norm, dim3(NT), dim3(256), 0, stream, (const float*)X, final_norm, (float*)d_out);
}
```

```cpp
#include <hip/hip_runtime.h>
#include <hip/hip_cooperative_groups.h>
#include <cstdio>
#include <cstdint>
namespace cg = cooperative_groups;

constexpr int NB = 4, SEQ = 2048, DM = 2048, NT = NB * SEQ, DEPTH = 2, NPROJ = 4608, FF = 8192, NMOD = 6, NJ = NMOD * DM;
constexpr int HD = 128;
constexpr float EPS = 1e-6f;
constexpr int NWAVES = 8, NTHREADS = NWAVES * 64;

constexpr size_t MiB = 1u << 20;
constexpr size_t WS_CTL = 0, CTL_ZERO_BYTES = 64 * 1024;
constexpr size_t WS_MOD = 1 * MiB;
constexpr size_t WS_ROPEA = 2 * MiB;
constexpr size_t WS_ROPEB = WS_ROPEA + (size_t)NT * 32 * 2 * 4;
constexpr size_t WS_WIN = 10 * MiB;
constexpr size_t WS_WOUT = WS_WIN + (size_t)DEPTH * NPROJ * DM * 2;
constexpr size_t WS_WUP = WS_WOUT + (size_t)DEPTH * DM * DM * 2;
constexpr size_t WS_WDN = WS_WUP + (size_t)DEPTH * FF * DM * 2;
constexpr size_t WS_X = WS_WDN + (size_t)DEPTH * DM * FF * 2;
constexpr size_t WS_H = WS_X + (size_t)NT * DM * 4;
constexpr size_t WS_PROJ = WS_H + (size_t)NT * DM * 2;
constexpr size_t WS_ATT = WS_PROJ + (size_t)NT * NPROJ * 2;
constexpr size_t WS_U = WS_ATT + (size_t)NT * DM * 2;
constexpr size_t WS_END = WS_U + (size_t)NT * FF * 2;
constexpr int CW_BAR = 1024;

constexpr int RING_OFF = 0, RING_BYTES = 131072;
constexpr int LDS_BYTES = 147456;
constexpr int LDSCTL_OFF = LDS_BYTES - 512, MISC_OFF = LDSCTL_OFF + 320;

namespace pg8 {
#define PG8_LAS __attribute__((address_space(3)))
typedef unsigned short bf16_t;
typedef short bf16x8 __attribute__((ext_vector_type(8)));
typedef float f32x4 __attribute__((ext_vector_type(4)));
typedef unsigned u32x4 __attribute__((ext_vector_type(4)));
constexpr int BM = 256, BK = 64, HALF = 128, HTB = HALF * BK * 2  , STAGE_BYTES = 8 * HTB, NXCD = 8, WGM = 8;

__host__ __device__ __forceinline__ int lds_byte(int r, int c) { const int st = (r >> 4) * 2 + (c >> 5), rr = r & 15, cc = c & 31, ob = rr * 64 + cc * 2; return st * 1024 + (ob ^ (((ob >> 9) & 1) << 5)); }
__host__ __device__ __forceinline__ void stage_rc(int b, int& R, int& C) { const int st = b / 1024, sb = b % 1024, swz = sb ^ (((sb >> 9) & 1) << 5); R = (st >> 1) * 16 + swz / 64; C = (st & 1) * 32 + (swz % 64) / 2; }
__host__ __device__ __forceinline__ int perm32(int rho) { const int n = rho >> 4, i = rho & 15; return 8 * (i >> 2) + 4 * n + (i & 3); }

struct Unit { int pm, pn; };
struct Gemm { const bf16_t* A; const bf16_t* Bt; int M, N, K; };

struct StaticOrder {
    int nM, nN, nwg, G, c;
    __host__ __device__ void init(int M, int N, int G_, int c_) { nM = M / BM; nN = N / BM; nwg = nM * nN; G = G_; c = c_; }
    __host__ __device__ bool next(int i, Unit& u) const {
        const long L = (long)i * G + c; if (L >= nwg) return false;
        int wgid = (int)L; { const int q = nwg / NXCD, r = nwg % NXCD, xcd = wgid % NXCD, off = wgid / NXCD; wgid = (xcd < r ? xcd * (q + 1) : r * (q + 1) + (xcd - r) * q) + off; }
        const int nig = WGM * nN, gid = wgid / nig, fm = gid * WGM, gsz = (nM - fm) < WGM ? (nM - fm) : WGM;
        u.pm = fm + ((wgid % nig) % gsz); u.pn = (wgid % nig) / gsz; return true;
    }
    __device__ __forceinline__ void a_ready(const Unit&) const {}
    __device__ __forceinline__ void done(const Unit&) const {}
};

__device__ __forceinline__ unsigned cvt_pk_bf16(float lo, float hi) { unsigned r; asm volatile("v_cvt_pk_bf16_f32 %0, %1, %2" : "=v"(r) : "v"(lo), "v"(hi)); return r; }
typedef float f32x2 __attribute__((ext_vector_type(2)));
struct EpiProj {
    static constexpr bool PERM = true, AFTER_DRAIN = false;
    bf16_t* P; const float* ra; const float* rb;
    __device__ __forceinline__ void operator()(const f32x4 (&acc)[2][2][4][2], const Unit& u, int wr, int wc, int fr, int fq) const {
        const int row0 = u.pm * BM + wr * 64 + fr, pn = u.pn;
        const int kind = pn < 8 ? 0 : ((pn >= 12 && pn <= 16) ? 2 : 1);
        if (kind == 1) {
            const int col0 = pn * BM + wc * 32 + 8 * fq;
#pragma unroll
            for (int ai = 0; ai < 2; ++ai)
#pragma unroll
                for (int m = 0; m < 4; ++m) { bf16_t* rowp = P + (size_t)(row0 + ai * HALF + m * 16) * NPROJ + col0;
#pragma unroll
                    for (int bj = 0; bj < 2; ++bj) { const f32x4 v0 = acc[ai][bj][m][0], v1 = acc[ai][bj][m][1];
                        u32x4 w; w.x = cvt_pk_bf16(v0[0], v0[1]); w.y = cvt_pk_bf16(v0[2], v0[3]); w.z = cvt_pk_bf16(v1[0], v1[1]); w.w = cvt_pk_bf16(v1[2], v1[3]);
                        *(u32x4*)(rowp + bj * HALF) = w; } }
        } else {
            const int ib = kind == 0 ? 8 * fq : 32 * (wc & 1) + 8 * fq;
            const int c1 = kind == 0 ? pn * BM + 64 * wc + 8 * fq : pn * BM + 128 * (wc >> 1) + ib;
            const int c2 = c1 + (kind == 0 ? 32 : 64);
            const float* tab = kind == 0 ? ra : rb; const int tw = kind == 0 ? 64 : 128;
#pragma unroll
            for (int ai = 0; ai < 2; ++ai)
#pragma unroll
                for (int m = 0; m < 4; ++m) { const int row = row0 + ai * HALF + m * 16;
                    const f32x4* tp = (const f32x4*)(tab + (size_t)row * tw + 2 * ib);
                    const f32x4 t0 = tp[0], t1 = tp[1], t2 = tp[2], t3 = tp[3];
                    const f32x4 x1a = acc[ai][0][m][0], x1b = acc[ai][0][m][1], x2a = acc[ai][1][m][0], x2b = acc[ai][1][m][1];
                    float o1[8], o2[8];
                    o1[0] = x1a[0] * t0[0] - x2a[0] * t0[1]; o2[0] = x2a[0] * t0[0] + x1a[0] * t0[1];
                    o1[1] = x1a[1] * t0[2] - x2a[1] * t0[3]; o2[1] = x2a[1] * t0[2] + x1a[1] * t0[3];
                    o1[2] = x1a[2] * t1[0] - x2a[2] * t1[1]; o2[2] = x2a[2] * t1[0] + x1a[2] * t1[1];
                    o1[3] = x1a[3] * t1[2] - x2a[3] * t1[3]; o2[3] = x2a[3] * t1[2] + x1a[3] * t1[3];
                    o1[4] = x1b[0] * t2[0] - x2b[0] * t2[1]; o2[4] = x2b[0] * t2[0] + x1b[0] * t2[1];
                    o1[5] = x1b[1] * t2[2] - x2b[1] * t2[3]; o2[5] = x2b[1] * t2[2] + x1b[1] * t2[3];
                    o1[6] = x1b[2] * t3[0] - x2b[2] * t3[1]; o2[6] = x2b[2] * t3[0] + x1b[2] * t3[1];
                    o1[7] = x1b[3] * t3[2] - x2b[3] * t3[3]; o2[7] = x2b[3] * t3[2] + x1b[3] * t3[3];
                    u32x4 w1, w2;
                    w1.x = cvt_pk_bf16(o1[0], o1[1]); w1.y = cvt_pk_bf16(o1[2], o1[3]); w1.z = cvt_pk_bf16(o1[4], o1[5]); w1.w = cvt_pk_bf16(o1[6], o1[7]);
                    w2.x = cvt_pk_bf16(o2[0], o2[1]); w2.y = cvt_pk_bf16(o2[2], o2[3]); w2.z = cvt_pk_bf16(o2[4], o2[5]); w2.w = cvt_pk_bf16(o2[6], o2[7]);
                    bf16_t* rowp = P + (size_t)row * NPROJ;
                    *(u32x4*)(rowp + c1) = w1; *(u32x4*)(rowp + c2) = w2; }
        }
    }
};
struct EpiRes {
    static constexpr bool PERM = false, AFTER_DRAIN = false;
    const float* xin; float* xout; const float* gate;
    __device__ __forceinline__ void operator()(const f32x4 (&acc)[2][2][4][2], const Unit& u, int wr, int wc, int fr, int fq) const {
        const int row0 = u.pm * BM + wr * 64 + fr, col0 = u.pn * BM + wc * 32 + 4 * fq;
        const int b = (u.pm * BM) / SEQ;
        f32x4 gv[2][2];
#pragma unroll
        for (int bj = 0; bj < 2; ++bj)
#pragma unroll
            for (int n = 0; n < 2; ++n) gv[bj][n] = *(const f32x4*)(gate + (size_t)b * NJ + col0 + bj * HALF + n * 16);
#pragma unroll
        for (int ai = 0; ai < 2; ++ai)
#pragma unroll
            for (int m = 0; m < 4; ++m) { const size_t off = (size_t)(row0 + ai * HALF + m * 16) * DM + col0;
#pragma unroll
                for (int bj = 0; bj < 2; ++bj)
#pragma unroll
                    for (int n = 0; n < 2; ++n) { const f32x4 xi = *(const f32x4*)(xin + off + bj * HALF + n * 16);
                        *(f32x4*)(xout + off + bj * HALF + n * 16) = xi + gv[bj][n] * acc[ai][bj][m][n]; } }
    }
};
struct EpiRelu2 {
    static constexpr bool PERM = true, AFTER_DRAIN = false;
    bf16_t* O; int ldc; int pad;
    __device__ __forceinline__ void operator()(const f32x4 (&acc)[2][2][4][2], const Unit& u, int wr, int wc, int fr, int fq) const {
        const int row0 = u.pm * BM + wr * 64 + fr, col0 = u.pn * BM + wc * 32 + 8 * fq;
#pragma unroll
        for (int ai = 0; ai < 2; ++ai)
#pragma unroll
            for (int m = 0; m < 4; ++m) { bf16_t* rowp = O + (size_t)(row0 + ai * HALF + m * 16) * ldc + col0;
#pragma unroll
                for (int bj = 0; bj < 2; ++bj) { f32x4 v0 = acc[ai][bj][m][0], v1 = acc[ai][bj][m][1];
                    v0 = __builtin_elementwise_max(v0, (f32x4){0.f, 0.f, 0.f, 0.f}); v1 = __builtin_elementwise_max(v1, (f32x4){0.f, 0.f, 0.f, 0.f});
                    v0 = v0 * v0; v1 = v1 * v1;
                    u32x4 w; w.x = cvt_pk_bf16(v0[0], v0[1]); w.y = cvt_pk_bf16(v0[2], v0[3]); w.z = cvt_pk_bf16(v1[0], v1[1]); w.w = cvt_pk_bf16(v1[2], v1[3]);
                    *(u32x4*)(rowp + bj * HALF) = w; } }
    }
};

template <class Epi, class Sched, bool ALIGN_EPI = false, bool SP2 = false>
__device__ __forceinline__ void gemm_phase(PG8_LAS unsigned char* lds, const Gemm g, const Sched& S, const Epi& E) {
    int tid_ = threadIdx.x; asm volatile("" : "+v"(tid_));
    const int tid = tid_, wid = __builtin_amdgcn_readfirstlane(tid >> 6), lane = tid & 63, wr = wid >> 2, wc = wid & 3, fr = lane & 15, fq = lane >> 4;
    const int K = g.K, nt = K / BK;
    unsigned voffA[2], voffB[2];
#pragma unroll
    for (int i = 0; i < 2; ++i) { int R, C; stage_rc(tid * 16 + i * 8192, R, C); const int Rb = Epi::PERM ? ((R & ~31) + perm32(R & 31)) : R;
        voffA[i] = (unsigned)(R * K + C) * 2u; voffB[i] = (unsigned)(Rb * K + C) * 2u; }
    const size_t kstep = (size_t)(BK * 2);
    const size_t hstep = (size_t)HALF * K * 2;
    const size_t tstep = 2 * hstep;
    const unsigned ldsw = (unsigned)wid * 1024u;
    const int aoff = lds_byte(wr * 64 + fr, fq * 8), boff = lds_byte(wc * 32 + fr, fq * 8);
#define PG8_SA(b, h) (((b) * 2 + (h)) * HTB)
#define PG8_SB(b, h) ((4 + (b) * 2 + (h)) * HTB)
#define PG8_STAGE(bufoff, gbase, voff) do { _Pragma("unroll") for (int _i = 0; _i < 2; ++_i) \
        __builtin_amdgcn_global_load_lds((const unsigned*)((const char*)(gbase) + (voff)[_i]), (PG8_LAS unsigned*)(lds + (bufoff) + ldsw + _i * 8192), 16, 0, 0); } while (0)
#define PG8_LDA(dst, b, h) do { _Pragma("unroll") for (int m = 0; m < 4; ++m) _Pragma("unroll") for (int k = 0; k < 2; ++k) dst[m][k] = *(const PG8_LAS bf16x8*)(lds + PG8_SA(b, h) + aoff + m * 2048 + k * 1024); } while (0)
#define PG8_LDB(dst, b, h) do { _Pragma("unroll") for (int n = 0; n < 2; ++n) _Pragma("unroll") for (int k = 0; k < 2; ++k) dst[n][k] = *(const PG8_LAS bf16x8*)(lds + PG8_SB(b, h) + boff + n * 2048 + k * 1024); } while (0)
#define PG8_MMA(ai, bj, At, Bt) do { __builtin_amdgcn_s_setprio(1); _Pragma("unroll") for (int m = 0; m < 4; ++m) _Pragma("unroll") for (int n = 0; n < 2; ++n) _Pragma("unroll") for (int k = 0; k < 2; ++k) \
        acc[ai][bj][m][n] = __builtin_amdgcn_mfma_f32_16x16x32_bf16(Bt[n][k], At[m][k], acc[ai][bj][m][n], 0, 0, 0); __builtin_amdgcn_s_setprio(0); } while (0)
#define PG8_WAIT_V(n) asm volatile("s_waitcnt vmcnt(" #n ")" ::: "memory")
#define PG8_WAIT_L(n) asm volatile("s_waitcnt lgkmcnt(" #n ")" ::: "memory")
#define PG8_BAR __builtin_amdgcn_s_barrier()
#define PG8_SCHED __builtin_amdgcn_sched_barrier(0)
    Unit cur, nxt; int ui = 0;
    if (!S.next(0, cur)) return;
    f32x4 acc[2][2][4][2];
#pragma unroll
    for (int a = 0; a < 2; ++a)
#pragma unroll
        for (int b = 0; b < 2; ++b)
#pragma unroll
            for (int m = 0; m < 4; ++m)
#pragma unroll
                for (int n = 0; n < 2; ++n) acc[a][b][m][n] = (f32x4){0.f, 0.f, 0.f, 0.f};
    bf16x8 At[4][2], B0[2][2], B1[2][2];
    const char* cA = (const char*)g.A + (size_t)cur.pm * tstep; const char* cB = (const char*)g.Bt + (size_t)cur.pn * tstep;
    S.a_ready(cur);
    if constexpr (SP2) {
        PG8_STAGE(PG8_SB(0, 0), cB, voffB); PG8_STAGE(PG8_SB(0, 1), cB + hstep, voffB); PG8_STAGE(PG8_SA(0, 0), cA, voffA); PG8_STAGE(PG8_SA(0, 1), cA + hstep, voffA);
        if (wr == 1) PG8_BAR;
        PG8_WAIT_V(2); PG8_BAR;
        PG8_STAGE(PG8_SB(1, 0), cB + kstep, voffB); PG8_STAGE(PG8_SA(1, 0), cA + kstep, voffA); PG8_STAGE(PG8_SB(1, 1), cB + hstep + kstep, voffB);
        PG8_WAIT_V(6); PG8_BAR;
    } else {
        PG8_STAGE(PG8_SB(0, 0), cB, voffB); PG8_STAGE(PG8_SA(0, 0), cA, voffA); PG8_STAGE(PG8_SB(0, 1), cB + hstep, voffB); PG8_STAGE(PG8_SA(0, 1), cA + hstep, voffA);
        if (wr == 1) PG8_BAR;
        PG8_WAIT_V(4); PG8_BAR;
        PG8_STAGE(PG8_SB(1, 0), cB + kstep, voffB); PG8_STAGE(PG8_SA(1, 0), cA + kstep, voffA); PG8_STAGE(PG8_SB(1, 1), cB + hstep + kstep, voffB);
        PG8_WAIT_V(6); PG8_BAR;
    }
    for (;;) {
        const bool has_next = S.next(ui + 1, nxt);
        const char* nA = has_next ? (const char*)g.A + (size_t)nxt.pm * tstep : cA; const char* nB = has_next ? (const char*)g.Bt + (size_t)nxt.pn * tstep : cB;
        for (int t = 0; t < nt; t += 2) {
            const bool last = (t == nt - 2);
            const char* a1 = cA + (size_t)(t + 1) * kstep;
            const char* a2 = last ? nA : cA + (size_t)(t + 2) * kstep; const char* b2 = last ? nB : cB + (size_t)(t + 2) * kstep;
            const char* a3 = a2 + kstep; const char* b3 = b2 + kstep;
            if (last && has_next) S.a_ready(nxt);
            if constexpr (SP2) {
            PG8_LDB(B0, 0, 0); PG8_LDB(B1, 0, 1); PG8_SCHED; PG8_LDA(At, 0, 0); PG8_STAGE(PG8_SA(1, 1), a1 + hstep, voffA);
            PG8_WAIT_V(8); PG8_WAIT_L(0); PG8_BAR; PG8_MMA(0, 0, At, B0); PG8_MMA(0, 1, At, B1); PG8_BAR; PG8_SCHED;
            PG8_LDA(At, 0, 1); PG8_STAGE(PG8_SB(0, 0), b2, voffB); PG8_STAGE(PG8_SB(0, 1), b2 + hstep, voffB); PG8_STAGE(PG8_SA(0, 0), a2, voffA);
            PG8_WAIT_V(8); PG8_WAIT_L(0); PG8_BAR; PG8_MMA(1, 0, At, B0); PG8_MMA(1, 1, At, B1); PG8_BAR; PG8_SCHED;
            PG8_LDB(B0, 1, 0); PG8_LDB(B1, 1, 1); PG8_SCHED; PG8_LDA(At, 1, 0); PG8_STAGE(PG8_SA(0, 1), a2 + hstep, voffA);
            PG8_WAIT_V(8); PG8_WAIT_L(0); PG8_BAR; PG8_MMA(0, 0, At, B0); PG8_MMA(0, 1, At, B1); PG8_BAR; PG8_SCHED;
            PG8_LDA(At, 1, 1); PG8_STAGE(PG8_SB(1, 0), b3, voffB); PG8_STAGE(PG8_SB(1, 1), b3 + hstep, voffB); PG8_STAGE(PG8_SA(1, 0), a3, voffA);
            PG8_WAIT_V(8); PG8_WAIT_L(0); PG8_BAR; PG8_MMA(1, 0, At, B0); PG8_MMA(1, 1, At, B1); PG8_BAR; PG8_SCHED;
            } else {
            PG8_LDB(B0, 0, 0); PG8_SCHED; PG8_LDA(At, 0, 0); PG8_STAGE(PG8_SA(1, 1), a1 + hstep, voffA);
            PG8_WAIT_L(8); PG8_BAR; PG8_WAIT_L(0); PG8_MMA(0, 0, At, B0); PG8_BAR; PG8_SCHED;
            PG8_LDB(B1, 0, 1); PG8_STAGE(PG8_SB(0, 0), b2, voffB);
            PG8_BAR; PG8_WAIT_L(0); PG8_MMA(0, 1, At, B1); PG8_BAR;
            PG8_LDA(At, 0, 1); PG8_STAGE(PG8_SA(0, 0), a2, voffA);
            PG8_BAR; PG8_WAIT_L(0); PG8_MMA(1, 0, At, B0); PG8_BAR; PG8_SCHED;
            PG8_STAGE(PG8_SB(0, 1), b2 + hstep, voffB);
            PG8_WAIT_V(6); PG8_BAR; PG8_MMA(1, 1, At, B1); PG8_BAR;
            PG8_LDB(B0, 1, 0); PG8_SCHED; PG8_LDA(At, 1, 0); PG8_STAGE(PG8_SA(0, 1), a2 + hstep, voffA);
            PG8_WAIT_L(8); PG8_BAR; PG8_WAIT_L(0); PG8_MMA(0, 0, At, B0); PG8_BAR; PG8_SCHED;
            PG8_LDB(B1, 1, 1); PG8_STAGE(PG8_SB(1, 0), b3, voffB);
            PG8_BAR; PG8_WAIT_L(0); PG8_MMA(0, 1, At, B1); PG8_BAR;
            PG8_LDA(At, 1, 1); PG8_STAGE(PG8_SA(1, 0), a3, voffA);
            PG8_BAR; PG8_WAIT_L(0); PG8_MMA(1, 0, At, B0); PG8_BAR; PG8_SCHED;
            PG8_STAGE(PG8_SB(1, 1), b3 + hstep, voffB);
            PG8_WAIT_V(6); PG8_BAR; PG8_MMA(1, 1, At, B1); PG8_BAR;
            }
        }
        if constexpr (ALIGN_EPI) { if (wr == 0) PG8_BAR; }
        if constexpr (!Epi::AFTER_DRAIN) { E(acc, cur, wr, wc, fr, fq); S.done(cur); }
        if (!has_next) break;
#pragma unroll
        for (int a = 0; a < 2; ++a)
#pragma unroll
            for (int b = 0; b < 2; ++b)
#pragma unroll
                for (int m = 0; m < 4; ++m)
#pragma unroll
                    for (int n = 0; n < 2; ++n) acc[a][b][m][n] = (f32x4){0.f, 0.f, 0.f, 0.f};
        cur = nxt; cA = nA; cB = nB; ++ui;
        if constexpr (ALIGN_EPI) { if (wr == 1) PG8_BAR; }
    }
    PG8_WAIT_V(0);
    if constexpr (!ALIGN_EPI) { if (wr == 0) PG8_BAR; }
    PG8_BAR;
    if constexpr (Epi::AFTER_DRAIN) { E.fused(acc, cur, wr, wc, fr, fq, lds, wid, lane); S.done(cur); }
#undef PG8_SA
#undef PG8_SB
#undef PG8_STAGE
#undef PG8_LDA
#undef PG8_LDB
#undef PG8_MMA
#undef PG8_WAIT_V
#undef PG8_WAIT_L
#undef PG8_BAR
#undef PG8_SCHED
}
}
#define GAS __attribute__((address_space(1)))
#define LAS __attribute__((address_space(3)))
typedef unsigned short bf16;
typedef unsigned v4u __attribute__((ext_vector_type(4)));
typedef float f32x4 __attribute__((ext_vector_type(4)));
typedef short bf16x8 __attribute__((ext_vector_type(8)));
typedef GAS unsigned gu32;
typedef GAS unsigned long long gu64;
#define RLX_AGENT __ATOMIC_RELAXED, __HIP_MEMORY_SCOPE_AGENT
#define LDS_WAIT() asm volatile("s_waitcnt lgkmcnt(0)" ::: "memory")
#define VM_WAIT() asm volatile("s_waitcnt vmcnt(0)" ::: "memory")
__device__ __forceinline__ unsigned long long rt() { return __builtin_amdgcn_s_memrealtime(); }
__device__ __forceinline__ unsigned f2bf(float f) { unsigned u = __builtin_bit_cast(unsigned, f); return (u + 0x7fffu + ((u >> 16) & 1u)) >> 16; }
__device__ __forceinline__ unsigned pk2(float lo, float hi) { return f2bf(lo) | (f2bf(hi) << 16); }

#define XB_TMO      128
#define XB_XCNT(j)  (256  + 64 * (j))
#define XB_XSUB(j)  (1280 + 64 * (j))
#define XB_XGEN(j)  (2304 + 64 * (j))
#define XB_TOP      3328
#define XB_TOPGEN   3392
#define XCD_BAR_WORDS 3456
#define XB_SPIN_CAP (1u << 27)

__device__ __forceinline__ unsigned xb_ld(unsigned* p)              { return __hip_atomic_load(p, __ATOMIC_RELAXED, __HIP_MEMORY_SCOPE_AGENT); }
__device__ __forceinline__ unsigned xb_add(unsigned* p, unsigned v) { return __hip_atomic_fetch_add(p, v, __ATOMIC_RELAXED, __HIP_MEMORY_SCOPE_AGENT); }
__device__ __forceinline__ unsigned xb_xcc_id() { return (unsigned)__builtin_amdgcn_s_getreg((3 << 11) | 20) & 0xFu; }
#define XB_SPIN(cond, bar) do { unsigned _sp = 0; while (cond) { __builtin_amdgcn_s_sleep(1); \
    if ((++_sp & 255u) == 0u) { if (xb_ld(&(bar)[XB_TMO])) break; if (_sp > XB_SPIN_CAP) { atomicAdd(&(bar)[XB_TMO], 1u); break; } } } } while (0)

struct XcdBarrier {
    unsigned* bar; unsigned x;
    volatile LAS unsigned* st;
};

__device__ __forceinline__ XcdBarrier xcd_barrier_post(unsigned* bar, volatile LAS unsigned* st) {
    XcdBarrier b; b.bar = bar; b.x = xb_xcc_id(); b.st = st;
    if (threadIdx.x == 0) (void)xb_add(&bar[XB_XCNT(b.x)], 1u);
    return b;
}
__device__ __forceinline__ void xcd_barrier_complete(unsigned* bar, unsigned x, unsigned& nloc, unsigned& nx) {
    const unsigned G = gridDim.x * gridDim.y * gridDim.z;
    unsigned sum, cnt, mine, sp = 0u;
    for (;;) {
        sum = 0u; cnt = 0u; mine = 0u;
#pragma unroll
        for (unsigned j = 0; j < 16; ++j) { const unsigned c = xb_ld(&bar[XB_XCNT(j)]); sum += c; cnt += (c > 0u) ? 1u : 0u; mine = (j == x) ? c : mine; }
        if (sum == G) break;
        __builtin_amdgcn_s_sleep(1);
        if ((++sp & 255u) == 0u) { if (xb_ld(&bar[XB_TMO])) break; if (sp > XB_SPIN_CAP) { atomicAdd(&bar[XB_TMO], 1u); break; } }
    }
    nloc = mine > 0u ? mine : 1u; nx = cnt > 0u ? cnt : 1u;
}

__device__ __forceinline__ void xcd_barrier(const XcdBarrier& b) {
    asm volatile("s_waitcnt vmcnt(0)" ::: "memory");
    __syncthreads();
    if (threadIdx.x == 0) {
        unsigned* bar = b.bar;
        __builtin_amdgcn_s_waitcnt(0);
        unsigned nloc = b.st[0], nx = b.st[1];
        if (nloc == 0u) { xcd_barrier_complete(bar, b.x, nloc, nx); b.st[0] = nloc; b.st[1] = nx; }
        const unsigned old = xb_add(&bar[XB_XSUB(b.x)], 1u);
        const unsigned gen = old / nloc;
        if (old + 1u == (gen + 1u) * nloc) {
            __builtin_amdgcn_fence(__ATOMIC_RELEASE, "agent");
            asm volatile("s_waitcnt vmcnt(0)" ::: "memory");
            const unsigned og = xb_add(&bar[XB_TOP], 1u);
            const unsigned tg = og / nx;
            if (og + 1u == (tg + 1u) * nx) xb_add(&bar[XB_TOPGEN], 1u);
            else XB_SPIN(xb_ld(&bar[XB_TOPGEN]) == tg, bar);
            __builtin_amdgcn_fence(__ATOMIC_ACQUIRE, "agent");
            xb_add(&bar[XB_XGEN(b.x)], 1u);
            asm volatile("s_waitcnt vmcnt(0)" ::: "memory");
        } else {
            XB_SPIN(xb_ld(&bar[XB_XGEN(b.x)]) == gen, bar);
            __builtin_amdgcn_fence(__ATOMIC_ACQUIRE, "agent");
            asm volatile("s_waitcnt vmcnt(0)" ::: "memory");
        }
    }
    __syncthreads();
}
__device__ __forceinline__ float bf2f(unsigned short h) { return __builtin_bit_cast(float, (unsigned)h << 16); }
__device__ __forceinline__ float wave_sum(float v) {
#pragma unroll
    for (int o = 1; o < 64; o <<= 1) v += __shfl_xor(v, o);
    return v;
}
__device__ __forceinline__ float wave_max(float v) {
#pragma unroll
    for (int o = 1; o < 64; o <<= 1) v = fmaxf(v, __shfl_xor(v, o));
    return v;
}
__host__ __device__ __forceinline__ int inproj_dst_row(int n) {
    const int pn = n >> 8, r = n & 255;
    if (pn < 8) return (pn << 8) + 128 * ((r >> 5) & 1) + 32 * (r >> 6) + (r & 31);
    if (pn >= 12 && pn <= 16) return (pn << 8) + 128 * ((r >> 6) & 1) + 64 * (r >> 7) + (r & 63);
    return n;
}

struct Params { const float* in[15]; float* out; unsigned char* ws; };

__device__ __forceinline__ void p0_rope_tables(const int* __restrict__ pos, float* __restrict__ ra, float* __restrict__ rb, int gtid, int gthreads) {
    for (int idx = gtid; idx < NT * 96; idx += gthreads) {
        const int t = idx / 96, j = idx % 96;
        const int dim = j < 32 ? 64 : 128, i = j < 32 ? j : j - 32;
        const float inv = (float)pow(10000.0, -(double)(2 * i) / (double)dim);
        const float ang = (float)pos[t] * inv;
        double sn, cs; sincos((double)ang, &sn, &cs);
        float* dst = j < 32 ? ra + ((size_t)t * 32 + i) * 2 : rb + ((size_t)t * 64 + i) * 2;
        dst[0] = (float)cs; dst[1] = (float)sn;
    }
}
__device__ __forceinline__ void p0_mod_item(const float* __restrict__ ada_w, const float* __restrict__ ada_b, float* __restrict__ mod, int item, unsigned char* lds, int wave, int lane, int tid) {
    const f32x4* cact = (const f32x4*)lds; float* red = (float*)(lds + 32768);
    const int col = item * 128, l = col / NJ, j = col % NJ;
    typedef float f32x2 __attribute__((ext_vector_type(2)));
    const float* w = ada_w + (size_t)l * DM * NJ + j + 2 * lane;
    f32x2 a0 = {0.f, 0.f}, a1 = {0.f, 0.f}, a2 = {0.f, 0.f}, a3 = {0.f, 0.f};
    const int k0 = wave * 256;
#pragma unroll 8
    for (int k = k0; k < k0 + 256; ++k) { const f32x2 wv = *(const f32x2*)(w + (size_t)k * NJ); const f32x4 cv = cact[k];
        a0 += wv * cv[0]; a1 += wv * cv[1]; a2 += wv * cv[2]; a3 += wv * cv[3]; }
    float* rw = red + wave * 512;
    rw[0 * 64 + lane] = a0[0]; rw[1 * 64 + lane] = a0[1]; rw[2 * 64 + lane] = a1[0]; rw[3 * 64 + lane] = a1[1];
    rw[4 * 64 + lane] = a2[0]; rw[5 * 64 + lane] = a2[1]; rw[6 * 64 + lane] = a3[0]; rw[7 * 64 + lane] = a3[1];
    __syncthreads();
    {
        const int b = tid >> 7, cc = tid & 127; float s = 0.f;
#pragma unroll
        for (int wv = 0; wv < 8; ++wv) s += red[wv * 512 + (b * 2 + (cc & 1)) * 64 + (cc >> 1)];
        mod[((size_t)l * NB + b) * NJ + j + cc] = s + ada_b[(size_t)l * NJ + j + cc];
    }
    __syncthreads();
}
template <bool PERMUTE>
__device__ __forceinline__ void p0_wt_tile(const float* __restrict__ W, int K, int N, bf16* __restrict__ Wt, int kb, int nb, unsigned char* lds, int wave, int lane, int tid) {
    unsigned char* tl = lds + 65536;
    const int k0 = kb * 64 + wave * 8, n0 = nb * 256;
    float v[4][8];
#pragma unroll
    for (int kk = 0; kk < 8; ++kk)
#pragma unroll
        for (int e = 0; e < 4; ++e) v[e][kk] = W[(size_t)(k0 + kk) * N + n0 + lane + 64 * e];
#pragma unroll
    for (int e = 0; e < 4; ++e) { v4u o; o.x = pk2(v[e][0], v[e][1]); o.y = pk2(v[e][2], v[e][3]); o.z = pk2(v[e][4], v[e][5]); o.w = pk2(v[e][6], v[e][7]);
        *(v4u*)(tl + (lane + 64 * e) * 144 + wave * 16) = o; }
    __syncthreads();
#pragma unroll
    for (int i = 0; i < 4; ++i) { const int r = i * 64 + (tid >> 3), ch = tid & 7; const v4u o = *(const v4u*)(tl + r * 144 + ch * 16);
        const int dr = PERMUTE ? inproj_dst_row(n0 + r) : n0 + r;
        *(v4u*)(Wt + (size_t)dr * K + kb * 64 + ch * 8) = o; }
    __syncthreads();
}
__device__ __forceinline__ void norm_mod_row(const float* __restrict__ xrow, const float* __restrict__ g, const float* __restrict__ sh, const float* __restrict__ sc, bf16* __restrict__ hrow, int lane) {
    const f32x4* xr = (const f32x4*)xrow + lane;
    f32x4 v[8]; float s = 0.f;
#pragma unroll
    for (int j = 0; j < 8; ++j) { v[j] = xr[64 * j]; s += (v[j][0] * v[j][0] + v[j][1] * v[j][1]) + (v[j][2] * v[j][2] + v[j][3] * v[j][3]); }
    const float rstd = rsqrtf(wave_sum(s) * (1.f / DM) + EPS);
    unsigned long long* o8 = (unsigned long long*)hrow + lane;
#pragma unroll
    for (int j = 0; j < 8; ++j) { const f32x4 gv = ((const f32x4*)g)[lane + 64 * j], sv = ((const f32x4*)sc)[lane + 64 * j], hv = ((const f32x4*)sh)[lane + 64 * j];
        f32x4 y = (v[j] * rstd) * gv; y = y * (sv + 1.0f) + hv;
        o8[64 * j] = (unsigned long long)pk2(y[0], y[1]) | ((unsigned long long)pk2(y[2], y[3]) << 32); }
}
__device__ __forceinline__ void final_norm_row(const float* __restrict__ xrow, const float* __restrict__ g, float* __restrict__ orow, int lane) {
    const f32x4* xr = (const f32x4*)xrow + lane;
    f32x4 v[8]; float s = 0.f;
#pragma unroll
    for (int j = 0; j < 8; ++j) { v[j] = xr[64 * j]; s += (v[j][0] * v[j][0] + v[j][1] * v[j][1]) + (v[j][2] * v[j][2] + v[j][3] * v[j][3]); }
    const float rstd = rsqrtf(wave_sum(s) * (1.f / DM) + EPS);
#pragma unroll
    for (int j = 0; j < 8; ++j) ((f32x4*)orow)[lane + 64 * j] = (v[j] * rstd) * ((const f32x4*)g)[lane + 64 * j];
}

__device__ __forceinline__ void diff_attn_row(const bf16* __restrict__ proj, float lam, float lam_init, const float* __restrict__ subln, bf16* __restrict__ att, int gid, float* wl, int lane) {
    float* q = wl; float* l1 = q + 128; float* l2 = l1 + SEQ;
    const int s = gid % SEQ, h = (gid / SEQ) % 8, b = gid / (SEQ * 8);
    const size_t trow = (size_t)b * SEQ + s;
    const bf16* qp = proj + trow * NPROJ + h * 128;
    q[lane] = bf2f(qp[lane]) * 0.125f; q[64 + lane] = bf2f(qp[64 + lane]) * 0.125f;
    LDS_WAIT();
    float m1 = -1e30f, m2 = -1e30f;
    for (int j = lane; j < SEQ; j += 64) {
        const bf16* kp = proj + ((size_t)b * SEQ + j) * NPROJ + 1024 + h * 128;
        float d1 = 0, d2 = 0;
#pragma unroll
        for (int d = 0; d < 64; d += 8) { const bf16x8 k1 = *(const bf16x8*)(kp + d), k2 = *(const bf16x8*)(kp + 64 + d);
#pragma unroll
            for (int e = 0; e < 8; ++e) { d1 += q[d + e] * bf2f((unsigned short)k1[e]); d2 += q[64 + d + e] * bf2f((unsigned short)k2[e]); } }
        l1[j] = d1; l2[j] = d2; m1 = fmaxf(m1, d1); m2 = fmaxf(m2, d2);
    }
    m1 = wave_max(m1); m2 = wave_max(m2);
    float s1 = 0, s2 = 0;
    for (int j = lane; j < SEQ; j += 64) { const float e1 = __expf(l1[j] - m1), e2 = __expf(l2[j] - m2); l1[j] = e1; l2[j] = e2; s1 += e1; s2 += e2; }
    s1 = wave_sum(s1); s2 = wave_sum(s2);
    const float i1 = 1.f / s1, i2 = lam / s2;
    for (int j = lane; j < SEQ; j += 64) l1[j] = l1[j] * i1 - l2[j] * i2;
    LDS_WAIT();
    float o0 = 0, o1 = 0;
    const bf16* vp = proj + (size_t)b * SEQ * NPROJ + 2048 + h * 128;
    for (int j = 0; j < SEQ; ++j) { const float wj = l1[j]; o0 += wj * bf2f(vp[(size_t)j * NPROJ + lane]); o1 += wj * bf2f(vp[(size_t)j * NPROJ + 64 + lane]); }
    const float ss = wave_sum(o0 * o0 + o1 * o1);
    const float r = rsqrtf(ss * (1.f / 128.f) + EPS) * (1.f - lam_init);
    att[trow * DM + h * 128 + lane] = (bf16)f2bf(o0 * r * subln[lane]);
    att[trow * DM + h * 128 + 64 + lane] = (bf16)f2bf(o1 * r * subln[64 + lane]);
    LDS_WAIT();
}
__device__ __forceinline__ void swa_row(const bf16* __restrict__ proj, const float* __restrict__ sink, bf16* __restrict__ att, int gid, float* wl, int lane) {
    float* q = wl; float* p = q + 128;
    const int s = gid % SEQ, h = (gid / SEQ) % 8, b = gid / (SEQ * 8), g = h / 4;
    const size_t trow = (size_t)b * SEQ + s;
    const bf16* qp = proj + trow * NPROJ + 3072 + h * 128;
    const float scale = 0.08838834764831845f;
    q[lane] = bf2f(qp[lane]) * scale; q[64 + lane] = bf2f(qp[64 + lane]) * scale;
    LDS_WAIT();
    const int j0 = s - 128; const float sk = sink[h];
    float lg[5]; float m = sk;
#pragma unroll
    for (int r = 0; r < 5; ++r) { const int jj = lane + 64 * r, j = j0 + jj; lg[r] = -1e30f;
        if (jj <= 256 && j >= 0 && j < SEQ) { const bf16* kp = proj + ((size_t)b * SEQ + j) * NPROJ + 4096 + g * 128; float d = 0;
#pragma unroll
            for (int dd = 0; dd < 128; dd += 8) { const bf16x8 kv = *(const bf16x8*)(kp + dd);
#pragma unroll
                for (int e = 0; e < 8; ++e) d += q[dd + e] * bf2f((unsigned short)kv[e]); }
            lg[r] = d; }
        m = fmaxf(m, lg[r]); }
    m = wave_max(m);
    float sum = 0;
#pragma unroll
    for (int r = 0; r < 5; ++r) { const float e = lg[r] > -1e29f ? __expf(lg[r] - m) : 0.f; p[lane + 64 * r] = e; sum += e; }
    sum = wave_sum(sum) + __expf(sk - m);
    const float inv = 1.f / sum;
    LDS_WAIT();
    float o0 = 0, o1 = 0;
    const bf16* vp = proj + (size_t)b * SEQ * NPROJ + 4352 + g * 128;
    for (int jj = 0; jj <= 256; ++jj) { const int j = j0 + jj; if (j < 0 || j >= SEQ) continue; const float pj = p[jj];
        o0 += pj * bf2f(vp[(size_t)j * NPROJ + lane]); o1 += pj * bf2f(vp[(size_t)j * NPROJ + 64 + lane]); }
    att[trow * DM + 1024 + h * 128 + lane] = (bf16)f2bf(o0 * inv);
    att[trow * DM + 1024 + h * 128 + 64 + lane] = (bf16)f2bf(o1 * inv);
    LDS_WAIT();
}

__global__ void __launch_bounds__(NTHREADS, 2) mega_fwd(Params p) {
    extern __shared__ __attribute__((aligned(16))) unsigned char lds_raw[];
    LAS unsigned char* lds = (LAS unsigned char*)lds_raw;
    const int tid = threadIdx.x, lane = tid & 63, wave = __builtin_amdgcn_readfirstlane(tid >> 6);
    const int G = gridDim.x, bid = blockIdx.x;
    const int gwave = bid * NWAVES + wave, NGW = G * NWAVES;
    unsigned char* ws = p.ws;
    gu32* ctl = (gu32*)(ws + WS_CTL);
    const float* x = p.in[0]; const float* c = p.in[1]; const int* pos = (const int*)p.in[2];
    const float* ada_w = p.in[3]; const float* ada_b = p.in[4]; const float* norm_mix = p.in[5];
    const float* w_in = p.in[6]; const float* diff_lambda = p.in[7]; const float* diff_subln = p.in[8];
    const float* swa_sink = p.in[9]; const float* w_out = p.in[10]; const float* norm_mlp = p.in[11];
    const float* w_up = p.in[12]; const float* w_down = p.in[13]; const float* final_norm = p.in[14];
    float* mod = (float*)(ws + WS_MOD); float* ra = (float*)(ws + WS_ROPEA); float* rb = (float*)(ws + WS_ROPEB);
    bf16* Win = (bf16*)(ws + WS_WIN); bf16* Wout = (bf16*)(ws + WS_WOUT); bf16* Wup = (bf16*)(ws + WS_WUP); bf16* Wdn = (bf16*)(ws + WS_WDN);
    float* X = (float*)(ws + WS_X); bf16* H = (bf16*)(ws + WS_H); bf16* PROJ = (bf16*)(ws + WS_PROJ); bf16* ATT = (bf16*)(ws + WS_ATT); bf16* U = (bf16*)(ws + WS_U);

    for (int u = tid; u < (LDS_BYTES - LDSCTL_OFF) / 4; u += NTHREADS) ((LAS unsigned*)(lds + LDSCTL_OFF))[u] = 0u;
    __syncthreads();
    XcdBarrier bar = xcd_barrier_post((unsigned*)(ctl + CW_BAR), (volatile LAS unsigned*)(lds + MISC_OFF) + 8);
#define GRID_BAR() xcd_barrier(bar)
#define PHASE_LOCALS() int ln = lane, gw = gwave; asm volatile("" : "+v"(ln)); asm volatile("" : "+s"(gw))

    {
        p0_rope_tables(pos, ra, rb, bid * NTHREADS + tid, G * NTHREADS);
        { float* cact = (float*)lds_raw; for (int i = tid; i < NB * DM; i += NTHREADS) { const float v = c[i]; cact[(i % DM) * 4 + i / DM] = v / (1.f + __expf(-v)); } }
        __syncthreads();
        constexpr int N_MOD_ITEMS = DEPTH * NJ / 128;
        for (int it = bid; it < N_MOD_ITEMS; it += G) p0_mod_item(ada_w, ada_b, mod, it, lds_raw, wave, lane, tid);
        constexpr int T_IN = 32 * 18, T_OUT = 32 * 8, T_UP = 32 * 32, T_DN = 128 * 8, T_L = T_IN + T_OUT + T_UP + T_DN, T_ALL = DEPTH * T_L;
        for (int it = bid; it < T_ALL; it += G) {
            const int l = it / T_L; int r = it % T_L;
            if (r < T_IN) { p0_wt_tile<true>(w_in + (size_t)l * DM * NPROJ, DM, NPROJ, Win + (size_t)l * NPROJ * DM, r / 18, r % 18, lds_raw, wave, lane, tid); continue; } r -= T_IN;
            if (r < T_OUT) { p0_wt_tile<false>(w_out + (size_t)l * DM * DM, DM, DM, Wout + (size_t)l * DM * DM, r / 8, r % 8, lds_raw, wave, lane, tid); continue; } r -= T_OUT;
            if (r < T_UP) { p0_wt_tile<false>(w_up + (size_t)l * DM * FF, DM, FF, Wup + (size_t)l * FF * DM, r / 32, r % 32, lds_raw, wave, lane, tid); continue; } r -= T_UP;
            p0_wt_tile<false>(w_down + (size_t)l * FF * DM, FF, DM, Wdn + (size_t)l * DM * FF, r / 8, r % 8, lds_raw, wave, lane, tid);
        }
    }
    cg::this_grid().sync();
    GRID_BAR();

    for (int l = 0; l < DEPTH; ++l) {
        const float* modl = mod + (size_t)l * NB * NJ;
        const float* xin = l == 0 ? x : X;
        const float lam_init = 0.8f - 0.6f * __expf(-0.3f * (float)l);
        { PHASE_LOCALS(); for (int m = gw; m < NT; m += NGW) { const int b = m / SEQ;
            norm_mod_row(xin + (size_t)m * DM, norm_mix + (size_t)l * DM, modl + (size_t)b * NJ + 0 * DM, modl + (size_t)b * NJ + 1 * DM, H + (size_t)m * DM, ln); } }
        GRID_BAR();
        { pg8::Gemm g{H, Win + (size_t)l * NPROJ * DM, NT, NPROJ, DM}; int c_ = bid; asm volatile("" : "+s"(c_)); pg8::StaticOrder S; S.init(NT, NPROJ, G, c_);
          pg8::EpiProj E{PROJ, ra, rb};
          pg8::gemm_phase<pg8::EpiProj, pg8::StaticOrder, true, true>(lds + RING_OFF, g, S, E); }
        GRID_BAR();
        {
            PHASE_LOCALS();
            float* wl = (float*)lds_raw + (gw % NWAVES) * (128 + 2 * SEQ);
            const float* lp = diff_lambda + (size_t)l * 256;
            const float lam = __expf(wave_sum(lp[ln] * lp[64 + ln])) - __expf(wave_sum(lp[128 + ln] * lp[192 + ln])) + lam_init;
            for (int gid = gw; gid < NB * 8 * SEQ; gid += NGW) diff_attn_row(PROJ, lam, lam_init, diff_subln + (size_t)l * HD, ATT, gid, wl, ln);
            for (int gid = gw; gid < NB * 8 * SEQ; gid += NGW) swa_row(PROJ, swa_sink + (size_t)l * 8, ATT, gid, wl, ln);
        }
        GRID_BAR();
        { pg8::Gemm g{ATT, Wout + (size_t)l * DM * DM, NT, DM, DM}; int c_ = bid; asm volatile("" : "+s"(c_)); pg8::StaticOrder S; S.init(NT, DM, G, c_);
          pg8::EpiRes E{xin, X, modl + 2 * DM};
          pg8::gemm_phase<pg8::EpiRes, pg8::StaticOrder, true, true>(lds + RING_OFF, g, S, E); }
        GRID_BAR();
        { PHASE_LOCALS(); for (int m = gw; m < NT; m += NGW) { const int b = m / SEQ;
            norm_mod_row(X + (size_t)m * DM, norm_mlp + (size_t)l * DM, modl + (size_t)b * NJ + 3 * DM, modl + (size_t)b * NJ + 4 * DM, H + (size_t)m * DM, ln); } }
        GRID_BAR();
        { pg8::Gemm g{H, Wup + (size_t)l * FF * DM, NT, FF, DM}; int c_ = bid; asm volatile("" : "+s"(c_)); pg8::StaticOrder S; S.init(NT, FF, G, c_);
          pg8::EpiRelu2 E{U, FF, 0};
          pg8::gemm_phase<pg8::EpiRelu2, pg8::StaticOrder, true, true>(lds + RING_OFF, g, S, E); }
        GRID_BAR();
        { pg8::Gemm g{U, Wdn + (size_t)l * DM * FF, NT, DM, FF}; int c_ = bid; asm volatile("" : "+s"(c_)); pg8::StaticOrder S; S.init(NT, DM, G, c_);
          pg8::EpiRes E{X, X, modl + 5 * DM};
          pg8::gemm_phase<pg8::EpiRes, pg8::StaticOrder, true, true>(lds + RING_OFF, g, S, E); }
        GRID_BAR();
    }
    { PHASE_LOCALS(); for (int m = gw; m < NT; m += NGW) final_norm_row(X + (size_t)m * DM, final_norm, p.out + (size_t)m * DM, ln); }
}

extern "C" void kernel_launch(void* const* d_in, const int* in_sizes, int n_in, void* d_out, int out_size, void* d_ws, size_t ws_size, hipStream_t stream) {
    static int grid = 0;
    if (grid == 0) {
        if (n_in != 15 || out_size != NT * DM || ws_size < WS_END) { fprintf(stderr, "kernel_launch: unexpected shapes n_in %d out %d ws %zu (need %zu)\n", n_in, out_size, ws_size, (size_t)WS_END); grid = -1; return; }
        int dev = 0, cus = 0, per_cu = 0;
        if (hipGetDevice(&dev) != hipSuccess || hipDeviceGetAttribute(&cus, hipDeviceAttributeMultiprocessorCount, dev) != hipSuccess) { fprintf(stderr, "kernel_launch: device query failed\n"); grid = -1; return; }
        if (hipFuncSetAttribute((const void*)mega_fwd, hipFuncAttributeMaxDynamicSharedMemorySize, LDS_BYTES) != hipSuccess) { fprintf(stderr, "kernel_launch: hipFuncSetAttribute failed\n"); grid = -1; return; }
        if (hipOccupancyMaxActiveBlocksPerMultiprocessor(&per_cu, (const void*)mega_fwd, NTHREADS, LDS_BYTES) != hipSuccess || per_cu < 1) { fprintf(stderr, "kernel_launch: occupancy query says %d blocks per CU\n", per_cu); (void)hipGetLastError(); grid = -1; return; }
        grid = cus;
    }
    if (grid < 0) return;
    if (hipMemsetAsync((char*)d_ws + WS_CTL, 0, CTL_ZERO_BYTES, stream) != hipSuccess) { fprintf(stderr, "kernel_launch: memset failed\n"); return; }
    Params prm{};
    for (int i = 0; i < 15; ++i) prm.in[i] = (const float*)d_in[i];
    prm.out = (float*)d_out; prm.ws = (unsigned char*)d_ws;
    void* args[] = {&prm};
    hipError_t e = hipLaunchCooperativeKernel((const void*)mega_fwd, dim3(grid), dim3(NTHREADS), args, LDS_BYTES, stream);
    if (e != hipSuccess) fprintf(stderr, "kernel_launch: cooperative launch failed: %s (grid %d)\n", hipGetErrorString(e), grid);
}
```

```cpp
#include <hip/hip_runtime.h>
#include <hip/hip_cooperative_groups.h>
#include <cstdio>
#include <cstdint>
namespace cg = cooperative_groups;

constexpr int NB = 4, SEQ = 2048, DM = 2048, NT = NB * SEQ, DEPTH = 2, NPROJ = 4608, FF = 8192, NMOD = 6, NJ = NMOD * DM;
constexpr int HD = 128;
constexpr float EPS = 1e-6f;
constexpr int NWAVES = 8, NTHREADS = NWAVES * 64;

constexpr size_t MiB = 1u << 20;
constexpr size_t WS_CTL = 0, CTL_ZERO_BYTES = 64 * 1024;
constexpr size_t WS_MOD = 1 * MiB;
constexpr size_t WS_ROPEA = 2 * MiB;
constexpr size_t WS_ROPEB = WS_ROPEA + (size_t)NT * 32 * 2 * 4;
constexpr size_t WS_WIN = 10 * MiB;
constexpr size_t WS_WOUT = WS_WIN + (size_t)DEPTH * NPROJ * DM * 2;
constexpr size_t WS_WUP = WS_WOUT + (size_t)DEPTH * DM * DM * 2;
constexpr size_t WS_WDN = WS_WUP + (size_t)DEPTH * FF * DM * 2;
constexpr size_t WS_X = WS_WDN + (size_t)DEPTH * DM * FF * 2;
constexpr size_t WS_H = WS_X + (size_t)NT * DM * 4;
constexpr size_t WS_PROJ = WS_H + (size_t)NT * DM * 2;
constexpr size_t WS_ATT = WS_PROJ + (size_t)NT * NPROJ * 2;
constexpr size_t WS_U = WS_ATT + (size_t)NT * DM * 2;
constexpr size_t WS_END = WS_U + (size_t)NT * FF * 2;
constexpr int CW_BAR = 1024;

constexpr int RING_OFF = 0, RING_BYTES = 131072;
constexpr int LDS_BYTES = 147456;
constexpr int LDSCTL_OFF = LDS_BYTES - 512, MISC_OFF = LDSCTL_OFF + 320;


__device__ __forceinline__ int lane_id() { int l; asm volatile("v_mbcnt_lo_u32_b32 %0, -1, 0\n\tv_mbcnt_hi_u32_b32 %0, -1, %0" : "=v"(l)); return l; }
namespace pg8 {
#define PG8_LAS __attribute__((address_space(3)))
typedef unsigned short bf16_t;
typedef short bf16x8 __attribute__((ext_vector_type(8)));
typedef float f32x4 __attribute__((ext_vector_type(4)));
typedef unsigned u32x4 __attribute__((ext_vector_type(4)));
constexpr int BM = 256, BK = 64, HALF = 128, HTB = HALF * BK * 2  , STAGE_BYTES = 8 * HTB, NXCD = 8, WGM = 8;

__host__ __device__ __forceinline__ int lds_byte(int r, int c) { const int st = (r >> 4) * 2 + (c >> 5), rr = r & 15, cc = c & 31, ob = rr * 64 + cc * 2; return st * 1024 + (ob ^ (((ob >> 9) & 1) << 5)); }
__host__ __device__ __forceinline__ void stage_rc(int b, int& R, int& C) { const int st = b / 1024, sb = b % 1024, swz = sb ^ (((sb >> 9) & 1) << 5); R = (st >> 1) * 16 + swz / 64; C = (st & 1) * 32 + (swz % 64) / 2; }
__host__ __device__ __forceinline__ int perm32(int rho) { const int n = rho >> 4, i = rho & 15; return 8 * (i >> 2) + 4 * n + (i & 3); }

struct Unit { int pm, pn; };
struct Gemm { const bf16_t* A; const bf16_t* Bt; int M, N, K; };

struct StaticOrder {
    int nM, nN, nwg, G, c;
    __host__ __device__ void init(int M, int N, int G_, int c_) { nM = M / BM; nN = N / BM; nwg = nM * nN; G = G_; c = c_; }
    __host__ __device__ bool next(int i, Unit& u) const {
        const long L = (long)i * G + c; if (L >= nwg) return false;
        int wgid = (int)L; { const int q = nwg / NXCD, r = nwg % NXCD, xcd = wgid % NXCD, off = wgid / NXCD; wgid = (xcd < r ? xcd * (q + 1) : r * (q + 1) + (xcd - r) * q) + off; }
        const int nig = WGM * nN, gid = wgid / nig, fm = gid * WGM, gsz = (nM - fm) < WGM ? (nM - fm) : WGM;
        u.pm = fm + ((wgid % nig) % gsz); u.pn = (wgid % nig) / gsz; return true;
    }
    __device__ __forceinline__ void a_ready(const Unit&) const {}
    __device__ __forceinline__ void done(const Unit&) const {}
};

__device__ __forceinline__ unsigned cvt_pk_bf16(float lo, float hi) { unsigned r; asm volatile("v_cvt_pk_bf16_f32 %0, %1, %2" : "=v"(r) : "v"(lo), "v"(hi)); return r; }
typedef float f32x2 __attribute__((ext_vector_type(2)));
struct EpiProj {
    static constexpr bool PERM = true, AFTER_DRAIN = false;
    bf16_t* P; const float* ra; const float* rb;
    __device__ __forceinline__ void operator()(const f32x4 (&acc)[2][2][4][2], const Unit& u, int wr, int wc, int fr, int fq) const {
        const int row0 = u.pm * BM + wr * 64 + fr, pn = u.pn;
        const int kind = pn < 8 ? 0 : ((pn >= 12 && pn <= 16) ? 2 : 1);
        if (kind == 1) {
            const int col0 = pn * BM + wc * 32 + 8 * fq;
#pragma unroll
            for (int ai = 0; ai < 2; ++ai)
#pragma unroll
                for (int m = 0; m < 4; ++m) { bf16_t* rowp = P + (size_t)(row0 + ai * HALF + m * 16) * NPROJ + col0;
#pragma unroll
                    for (int bj = 0; bj < 2; ++bj) { const f32x4 v0 = acc[ai][bj][m][0], v1 = acc[ai][bj][m][1];
                        u32x4 w; w.x = cvt_pk_bf16(v0[0], v0[1]); w.y = cvt_pk_bf16(v0[2], v0[3]); w.z = cvt_pk_bf16(v1[0], v1[1]); w.w = cvt_pk_bf16(v1[2], v1[3]);
                        *(u32x4*)(rowp + bj * HALF) = w; } }
        } else {
            const int ib = kind == 0 ? 8 * fq : 32 * (wc & 1) + 8 * fq;
            const int c1 = kind == 0 ? pn * BM + 64 * wc + 8 * fq : pn * BM + 128 * (wc >> 1) + ib;
            const int c2 = c1 + (kind == 0 ? 32 : 64);
            const float* tab = kind == 0 ? ra : rb; const int tw = kind == 0 ? 64 : 128;
#pragma unroll
            for (int ai = 0; ai < 2; ++ai)
#pragma unroll
                for (int m = 0; m < 4; ++m) { const int row = row0 + ai * HALF + m * 16;
                    const f32x4* tp = (const f32x4*)(tab + (size_t)row * tw + 2 * ib);
                    const f32x4 t0 = tp[0], t1 = tp[1], t2 = tp[2], t3 = tp[3];
                    const f32x4 x1a = acc[ai][0][m][0], x1b = acc[ai][0][m][1], x2a = acc[ai][1][m][0], x2b = acc[ai][1][m][1];
                    float o1[8], o2[8];
                    o1[0] = x1a[0] * t0[0] - x2a[0] * t0[1]; o2[0] = x2a[0] * t0[0] + x1a[0] * t0[1];
                    o1[1] = x1a[1] * t0[2] - x2a[1] * t0[3]; o2[1] = x2a[1] * t0[2] + x1a[1] * t0[3];
                    o1[2] = x1a[2] * t1[0] - x2a[2] * t1[1]; o2[2] = x2a[2] * t1[0] + x1a[2] * t1[1];
                    o1[3] = x1a[3] * t1[2] - x2a[3] * t1[3]; o2[3] = x2a[3] * t1[2] + x1a[3] * t1[3];
                    o1[4] = x1b[0] * t2[0] - x2b[0] * t2[1]; o2[4] = x2b[0] * t2[0] + x1b[0] * t2[1];
                    o1[5] = x1b[1] * t2[2] - x2b[1] * t2[3]; o2[5] = x2b[1] * t2[2] + x1b[1] * t2[3];
                    o1[6] = x1b[2] * t3[0] - x2b[2] * t3[1]; o2[6] = x2b[2] * t3[0] + x1b[2] * t3[1];
                    o1[7] = x1b[3] * t3[2] - x2b[3] * t3[3]; o2[7] = x2b[3] * t3[2] + x1b[3] * t3[3];
                    u32x4 w1, w2;
                    w1.x = cvt_pk_bf16(o1[0], o1[1]); w1.y = cvt_pk_bf16(o1[2], o1[3]); w1.z = cvt_pk_bf16(o1[4], o1[5]); w1.w = cvt_pk_bf16(o1[6], o1[7]);
                    w2.x = cvt_pk_bf16(o2[0], o2[1]); w2.y = cvt_pk_bf16(o2[2], o2[3]); w2.z = cvt_pk_bf16(o2[4], o2[5]); w2.w = cvt_pk_bf16(o2[6], o2[7]);
                    bf16_t* rowp = P + (size_t)row * NPROJ;
                    *(u32x4*)(rowp + c1) = w1; *(u32x4*)(rowp + c2) = w2; }
        }
    }
};
struct EpiRes {
    static constexpr bool PERM = false, AFTER_DRAIN = false;
    const float* xin; float* xout; const float* gate;
    __device__ __forceinline__ void operator()(const f32x4 (&acc)[2][2][4][2], const Unit& u, int wr, int wc, int fr, int fq) const {
        const int row0 = u.pm * BM + wr * 64 + fr, col0 = u.pn * BM + wc * 32 + 4 * fq;
        const int b = (u.pm * BM) / SEQ;
        f32x4 gv[2][2];
#pragma unroll
        for (int bj = 0; bj < 2; ++bj)
#pragma unroll
            for (int n = 0; n < 2; ++n) gv[bj][n] = *(const f32x4*)(gate + (size_t)b * NJ + col0 + bj * HALF + n * 16);
#pragma unroll
        for (int ai = 0; ai < 2; ++ai)
#pragma unroll
            for (int m = 0; m < 4; ++m) { const size_t off = (size_t)(row0 + ai * HALF + m * 16) * DM + col0;
#pragma unroll
                for (int bj = 0; bj < 2; ++bj)
#pragma unroll
                    for (int n = 0; n < 2; ++n) { const f32x4 xi = *(const f32x4*)(xin + off + bj * HALF + n * 16);
                        *(f32x4*)(xout + off + bj * HALF + n * 16) = xi + gv[bj][n] * acc[ai][bj][m][n]; } }
    }
};
struct EpiRelu2 {
    static constexpr bool PERM = true, AFTER_DRAIN = false;
    bf16_t* O; int ldc; int pad;
    __device__ __forceinline__ void operator()(const f32x4 (&acc)[2][2][4][2], const Unit& u, int wr, int wc, int fr, int fq) const {
        const int row0 = u.pm * BM + wr * 64 + fr, col0 = u.pn * BM + wc * 32 + 8 * fq;
#pragma unroll
        for (int ai = 0; ai < 2; ++ai)
#pragma unroll
            for (int m = 0; m < 4; ++m) { bf16_t* rowp = O + (size_t)(row0 + ai * HALF + m * 16) * ldc + col0;
#pragma unroll
                for (int bj = 0; bj < 2; ++bj) { f32x4 v0 = acc[ai][bj][m][0], v1 = acc[ai][bj][m][1];
                    v0 = __builtin_elementwise_max(v0, (f32x4){0.f, 0.f, 0.f, 0.f}); v1 = __builtin_elementwise_max(v1, (f32x4){0.f, 0.f, 0.f, 0.f});
                    v0 = v0 * v0; v1 = v1 * v1;
                    u32x4 w; w.x = cvt_pk_bf16(v0[0], v0[1]); w.y = cvt_pk_bf16(v0[2], v0[3]); w.z = cvt_pk_bf16(v1[0], v1[1]); w.w = cvt_pk_bf16(v1[2], v1[3]);
                    *(u32x4*)(rowp + bj * HALF) = w; } }
    }
};

template <class Epi, class Sched, bool ALIGN_EPI = false, bool SP2 = false>
__device__ __forceinline__ void gemm_phase(PG8_LAS unsigned char* lds, const Gemm g, const Sched& S, const Epi& E, const int wave_id) {
    int tid_ = wave_id * 64 + lane_id(); asm volatile("" : "+v"(tid_));
    const int tid = tid_, wid = __builtin_amdgcn_readfirstlane(tid >> 6), lane = tid & 63, wr = wid >> 2, wc = wid & 3, fr = lane & 15, fq = lane >> 4;
    const int K = g.K, nt = K / BK;
    unsigned voffA[2], voffB[2];
#pragma unroll
    for (int i = 0; i < 2; ++i) { int R, C; stage_rc(tid * 16 + i * 8192, R, C); const int Rb = Epi::PERM ? ((R & ~31) + perm32(R & 31)) : R;
        voffA[i] = (unsigned)(R * K + C) * 2u; voffB[i] = (unsigned)(Rb * K + C) * 2u; }
    const size_t kstep = (size_t)(BK * 2);
    const size_t hstep = (size_t)HALF * K * 2;
    const size_t tstep = 2 * hstep;
    const unsigned ldsw = (unsigned)wid * 1024u;
    const int aoff = lds_byte(wr * 64 + fr, fq * 8), boff = lds_byte(wc * 32 + fr, fq * 8);
#define PG8_SA(b, h) (((b) * 2 + (h)) * HTB)
#define PG8_SB(b, h) ((4 + (b) * 2 + (h)) * HTB)
#define PG8_STAGE(bufoff, gbase, voff) do { _Pragma("unroll") for (int _i = 0; _i < 2; ++_i) \
        __builtin_amdgcn_global_load_lds((const unsigned*)((const char*)(gbase) + (voff)[_i]), (PG8_LAS unsigned*)(lds + (bufoff) + ldsw + _i * 8192), 16, 0, 0); } while (0)
#define PG8_LDA(dst, b, h) do { _Pragma("unroll") for (int m = 0; m < 4; ++m) _Pragma("unroll") for (int k = 0; k < 2; ++k) dst[m][k] = *(const PG8_LAS bf16x8*)(lds + PG8_SA(b, h) + aoff + m * 2048 + k * 1024); } while (0)
#define PG8_LDB(dst, b, h) do { _Pragma("unroll") for (int n = 0; n < 2; ++n) _Pragma("unroll") for (int k = 0; k < 2; ++k) dst[n][k] = *(const PG8_LAS bf16x8*)(lds + PG8_SB(b, h) + boff + n * 2048 + k * 1024); } while (0)
#define PG8_MMA(ai, bj, At, Bt) do { __builtin_amdgcn_s_setprio(1); _Pragma("unroll") for (int m = 0; m < 4; ++m) _Pragma("unroll") for (int n = 0; n < 2; ++n) _Pragma("unroll") for (int k = 0; k < 2; ++k) \
        acc[ai][bj][m][n] = __builtin_amdgcn_mfma_f32_16x16x32_bf16(Bt[n][k], At[m][k], acc[ai][bj][m][n], 0, 0, 0); __builtin_amdgcn_s_setprio(0); } while (0)
#define PG8_WAIT_V(n) asm volatile("s_waitcnt vmcnt(" #n ")" ::: "memory")
#define PG8_WAIT_L(n) asm volatile("s_waitcnt lgkmcnt(" #n ")" ::: "memory")
#define PG8_BAR __builtin_amdgcn_s_barrier()
#define PG8_SCHED __builtin_amdgcn_sched_barrier(0)
    Unit cur, nxt; int ui = 0;
    if (!S.next(0, cur)) return;
    f32x4 acc[2][2][4][2];
#pragma unroll
    for (int a = 0; a < 2; ++a)
#pragma unroll
        for (int b = 0; b < 2; ++b)
#pragma unroll
            for (int m = 0; m < 4; ++m)
#pragma unroll
                for (int n = 0; n < 2; ++n) acc[a][b][m][n] = (f32x4){0.f, 0.f, 0.f, 0.f};
    bf16x8 At[4][2], B0[2][2], B1[2][2];
    const char* cA = (const char*)g.A + (size_t)cur.pm * tstep; const char* cB = (const char*)g.Bt + (size_t)cur.pn * tstep;
    S.a_ready(cur);
    if constexpr (SP2) {
        PG8_STAGE(PG8_SB(0, 0), cB, voffB); PG8_STAGE(PG8_SB(0, 1), cB + hstep, voffB); PG8_STAGE(PG8_SA(0, 0), cA, voffA); PG8_STAGE(PG8_SA(0, 1), cA + hstep, voffA);
        if (wr == 1) PG8_BAR;
        PG8_WAIT_V(2); PG8_BAR;
        PG8_STAGE(PG8_SB(1, 0), cB + kstep, voffB); PG8_STAGE(PG8_SA(1, 0), cA + kstep, voffA); PG8_STAGE(PG8_SB(1, 1), cB + hstep + kstep, voffB);
        PG8_WAIT_V(6); PG8_BAR;
    } else {
        PG8_STAGE(PG8_SB(0, 0), cB, voffB); PG8_STAGE(PG8_SA(0, 0), cA, voffA); PG8_STAGE(PG8_SB(0, 1), cB + hstep, voffB); PG8_STAGE(PG8_SA(0, 1), cA + hstep, voffA);
        if (wr == 1) PG8_BAR;
        PG8_WAIT_V(4); PG8_BAR;
        PG8_STAGE(PG8_SB(1, 0), cB + kstep, voffB); PG8_STAGE(PG8_SA(1, 0), cA + kstep, voffA); PG8_STAGE(PG8_SB(1, 1), cB + hstep + kstep, voffB);
        PG8_WAIT_V(6); PG8_BAR;
    }
    for (;;) {
        const bool has_next = S.next(ui + 1, nxt);
        const char* nA = has_next ? (const char*)g.A + (size_t)nxt.pm * tstep : cA; const char* nB = has_next ? (const char*)g.Bt + (size_t)nxt.pn * tstep : cB;
        for (int t = 0; t < nt; t += 2) {
            const bool last = (t == nt - 2);
            const char* a1 = cA + (size_t)(t + 1) * kstep;
            const char* a2 = last ? nA : cA + (size_t)(t + 2) * kstep; const char* b2 = last ? nB : cB + (size_t)(t + 2) * kstep;
            const char* a3 = a2 + kstep; const char* b3 = b2 + kstep;
            if (last && has_next) S.a_ready(nxt);
            if constexpr (SP2) {
            PG8_LDB(B0, 0, 0); PG8_LDB(B1, 0, 1); PG8_SCHED; PG8_LDA(At, 0, 0); PG8_STAGE(PG8_SA(1, 1), a1 + hstep, voffA);
            PG8_WAIT_V(8); PG8_WAIT_L(0); PG8_BAR; PG8_MMA(0, 0, At, B0); PG8_MMA(0, 1, At, B1); PG8_BAR; PG8_SCHED;
            PG8_LDA(At, 0, 1); PG8_STAGE(PG8_SB(0, 0), b2, voffB); PG8_STAGE(PG8_SB(0, 1), b2 + hstep, voffB); PG8_STAGE(PG8_SA(0, 0), a2, voffA);
            PG8_WAIT_V(8); PG8_WAIT_L(0); PG8_BAR; PG8_MMA(1, 0, At, B0); PG8_MMA(1, 1, At, B1); PG8_BAR; PG8_SCHED;
            PG8_LDB(B0, 1, 0); PG8_LDB(B1, 1, 1); PG8_SCHED; PG8_LDA(At, 1, 0); PG8_STAGE(PG8_SA(0, 1), a2 + hstep, voffA);
            PG8_WAIT_V(8); PG8_WAIT_L(0); PG8_BAR; PG8_MMA(0, 0, At, B0); PG8_MMA(0, 1, At, B1); PG8_BAR; PG8_SCHED;
            PG8_LDA(At, 1, 1); PG8_STAGE(PG8_SB(1, 0), b3, voffB); PG8_STAGE(PG8_SB(1, 1), b3 + hstep, voffB); PG8_STAGE(PG8_SA(1, 0), a3, voffA);
            PG8_WAIT_V(8); PG8_WAIT_L(0); PG8_BAR; PG8_MMA(1, 0, At, B0); PG8_MMA(1, 1, At, B1); PG8_BAR; PG8_SCHED;
            } else {
            PG8_LDB(B0, 0, 0); PG8_SCHED; PG8_LDA(At, 0, 0); PG8_STAGE(PG8_SA(1, 1), a1 + hstep, voffA);
            PG8_WAIT_L(8); PG8_BAR; PG8_WAIT_L(0); PG8_MMA(0, 0, At, B0); PG8_BAR; PG8_SCHED;
            PG8_LDB(B1, 0, 1); PG8_STAGE(PG8_SB(0, 0), b2, voffB);
            PG8_BAR; PG8_WAIT_L(0); PG8_MMA(0, 1, At, B1); PG8_BAR;
            PG8_LDA(At, 0, 1); PG8_STAGE(PG8_SA(0, 0), a2, voffA);
            PG8_BAR; PG8_WAIT_L(0); PG8_MMA(1, 0, At, B0); PG8_BAR; PG8_SCHED;
            PG8_STAGE(PG8_SB(0, 1), b2 + hstep, voffB);
            PG8_WAIT_V(6); PG8_BAR; PG8_MMA(1, 1, At, B1); PG8_BAR;
            PG8_LDB(B0, 1, 0); PG8_SCHED; PG8_LDA(At, 1, 0); PG8_STAGE(PG8_SA(0, 1), a2 + hstep, voffA);
            PG8_WAIT_L(8); PG8_BAR; PG8_WAIT_L(0); PG8_MMA(0, 0, At, B0); PG8_BAR; PG8_SCHED;
            PG8_LDB(B1, 1, 1); PG8_STAGE(PG8_SB(1, 0), b3, voffB);
            PG8_BAR; PG8_WAIT_L(0); PG8_MMA(0, 1, At, B1); PG8_BAR;
            PG8_LDA(At, 1, 1); PG8_STAGE(PG8_SA(1, 0), a3, voffA);
            PG8_BAR; PG8_WAIT_L(0); PG8_MMA(1, 0, At, B0); PG8_BAR; PG8_SCHED;
            PG8_STAGE(PG8_SB(1, 1), b3 + hstep, voffB);
            PG8_WAIT_V(6); PG8_BAR; PG8_MMA(1, 1, At, B1); PG8_BAR;
            }
        }
        if constexpr (ALIGN_EPI) { if (wr == 0) PG8_BAR; }
        if constexpr (!Epi::AFTER_DRAIN) { E(acc, cur, wr, wc, fr, fq); S.done(cur); }
        if (!has_next) break;
#pragma unroll
        for (int a = 0; a < 2; ++a)
#pragma unroll
            for (int b = 0; b < 2; ++b)
#pragma unroll
                for (int m = 0; m < 4; ++m)
#pragma unroll
                    for (int n = 0; n < 2; ++n) acc[a][b][m][n] = (f32x4){0.f, 0.f, 0.f, 0.f};
        cur = nxt; cA = nA; cB = nB; ++ui;
        if constexpr (ALIGN_EPI) { if (wr == 1) PG8_BAR; }
    }
    PG8_WAIT_V(0);
    if constexpr (!ALIGN_EPI) { if (wr == 0) PG8_BAR; }
    PG8_BAR;
    if constexpr (Epi::AFTER_DRAIN) { E.fused(acc, cur, wr, wc, fr, fq, lds, wid, lane); S.done(cur); }
#undef PG8_SA
#undef PG8_SB
#undef PG8_STAGE
#undef PG8_LDA
#undef PG8_LDB
#undef PG8_MMA
#undef PG8_WAIT_V
#undef PG8_WAIT_L
#undef PG8_BAR
#undef PG8_SCHED
}
}
#define GAS __attribute__((address_space(1)))
#define LAS __attribute__((address_space(3)))
typedef unsigned short bf16;
typedef unsigned v4u __attribute__((ext_vector_type(4)));
typedef float f32x4 __attribute__((ext_vector_type(4)));
typedef short bf16x8 __attribute__((ext_vector_type(8)));
typedef GAS unsigned gu32;
typedef GAS unsigned long long gu64;
#define RLX_AGENT __ATOMIC_RELAXED, __HIP_MEMORY_SCOPE_AGENT
#define LDS_WAIT() asm volatile("s_waitcnt lgkmcnt(0)" ::: "memory")
#define VM_WAIT() asm volatile("s_waitcnt vmcnt(0)" ::: "memory")
__device__ __forceinline__ unsigned long long rt() { return __builtin_amdgcn_s_memrealtime(); }
__device__ __forceinline__ unsigned f2bf(float f) { unsigned u = __builtin_bit_cast(unsigned, f); return (u + 0x7fffu + ((u >> 16) & 1u)) >> 16; }
__device__ __forceinline__ unsigned pk2(float lo, float hi) { return f2bf(lo) | (f2bf(hi) << 16); }

#define XB_TMO      128
#define XB_XCNT(j)  (256  + 64 * (j))
#define XB_XSUB(j)  (1280 + 64 * (j))
#define XB_XGEN(j)  (2304 + 64 * (j))
#define XB_TOP      3328
#define XB_TOPGEN   3392
#define XCD_BAR_WORDS 3456
#define XB_SPIN_CAP (1u << 27)

__device__ __forceinline__ unsigned xb_ld(unsigned* p)              { return __hip_atomic_load(p, __ATOMIC_RELAXED, __HIP_MEMORY_SCOPE_AGENT); }
__device__ __forceinline__ unsigned xb_add(unsigned* p, unsigned v) { return __hip_atomic_fetch_add(p, v, __ATOMIC_RELAXED, __HIP_MEMORY_SCOPE_AGENT); }
__device__ __forceinline__ unsigned xb_xcc_id() { return (unsigned)__builtin_amdgcn_s_getreg((3 << 11) | 20) & 0xFu; }
#define XB_SPIN(cond, bar) do { unsigned _sp = 0; while (cond) { __builtin_amdgcn_s_sleep(1); \
    if ((++_sp & 255u) == 0u) { if (xb_ld(&(bar)[XB_TMO])) break; if (_sp > XB_SPIN_CAP) { atomicAdd(&(bar)[XB_TMO], 1u); break; } } } } while (0)

struct XcdBarrier {
    unsigned* bar; unsigned x;
    volatile LAS unsigned* st;
};

__device__ __forceinline__ XcdBarrier xcd_barrier_post(unsigned* bar, volatile LAS unsigned* st, bool tid0) {
    XcdBarrier b; b.bar = bar; b.x = xb_xcc_id(); b.st = st;
    if (tid0) (void)xb_add(&bar[XB_XCNT(b.x)], 1u);
    return b;
}
__device__ __forceinline__ void xcd_barrier_complete(unsigned* bar, unsigned x, unsigned& nloc, unsigned& nx) {
    const unsigned G = gridDim.x * gridDim.y * gridDim.z;
    unsigned sum, cnt, mine, sp = 0u;
    for (;;) {
        sum = 0u; cnt = 0u; mine = 0u;
#pragma unroll
        for (unsigned j = 0; j < 16; ++j) { const unsigned c = xb_ld(&bar[XB_XCNT(j)]); sum += c; cnt += (c > 0u) ? 1u : 0u; mine = (j == x) ? c : mine; }
        if (sum == G) break;
        __builtin_amdgcn_s_sleep(1);
        if ((++sp & 255u) == 0u) { if (xb_ld(&bar[XB_TMO])) break; if (sp > XB_SPIN_CAP) { atomicAdd(&bar[XB_TMO], 1u); break; } }
    }
    nloc = mine > 0u ? mine : 1u; nx = cnt > 0u ? cnt : 1u;
}

__device__ __forceinline__ void xcd_barrier(const XcdBarrier& b, bool tid0) {
    asm volatile("s_waitcnt vmcnt(0)" ::: "memory");
    __syncthreads();
    if (tid0) {
        unsigned* bar = b.bar;
        __builtin_amdgcn_s_waitcnt(0);
        unsigned nloc = b.st[0], nx = b.st[1];
        if (nloc == 0u) { xcd_barrier_complete(bar, b.x, nloc, nx); b.st[0] = nloc; b.st[1] = nx; }
        const unsigned old = xb_add(&bar[XB_XSUB(b.x)], 1u);
        const unsigned gen = old / nloc;
        if (old + 1u == (gen + 1u) * nloc) {
            __builtin_amdgcn_fence(__ATOMIC_RELEASE, "agent");
            asm volatile("s_waitcnt vmcnt(0)" ::: "memory");
            const unsigned og = xb_add(&bar[XB_TOP], 1u);
            const unsigned tg = og / nx;
            if (og + 1u == (tg + 1u) * nx) xb_add(&bar[XB_TOPGEN], 1u);
            else XB_SPIN(xb_ld(&bar[XB_TOPGEN]) == tg, bar);
            __builtin_amdgcn_fence(__ATOMIC_ACQUIRE, "agent");
            xb_add(&bar[XB_XGEN(b.x)], 1u);
            asm volatile("s_waitcnt vmcnt(0)" ::: "memory");
        } else {
            XB_SPIN(xb_ld(&bar[XB_XGEN(b.x)]) == gen, bar);
            __builtin_amdgcn_fence(__ATOMIC_ACQUIRE, "agent");
            asm volatile("s_waitcnt vmcnt(0)" ::: "memory");
        }
    }
    __syncthreads();
}
namespace att {
using bf16x8 = __attribute__((ext_vector_type(8))) short;
using s16x4  = __attribute__((ext_vector_type(4))) short;
using f32x16 = __attribute__((ext_vector_type(16))) float;
using u32x4  = __attribute__((ext_vector_type(4))) unsigned;
constexpr int KVBLK = 64, LDK = NPROJ;
constexpr int SHM_V = KVBLK * 128 * 2, SHM_K = KVBLK * 128 * 2, SHM_ATTN = 2 * SHM_V + 2 * SHM_K + NWAVES * 64 * 4;
constexpr float THR = 8.f;
#define KSWZ(row, colB) ((row) * 256 + ((colB) ^ (((row) & 7) << 4)))
#define SBAR() __builtin_amdgcn_sched_barrier(0)
__device__ __forceinline__ int crow(int r, int hi) { return (r & 3) + 8 * (r >> 2) + 4 * hi; }
__device__ __forceinline__ unsigned cvtpk(float lo, float hi) { unsigned r; asm volatile("v_cvt_pk_bf16_f32 %0, %1, %2" : "=v"(r) : "v"(lo), "v"(hi)); return r; }

template <int MODE> __device__ __forceinline__ void partialSM(f32x16& p0, f32x16& p1, float& m_reg, float& mn, float& alpha) {
  constexpr float SCALE = MODE == 0 ? 0.125f : 0.088388347648318440f;
  constexpr float C = SCALE * 1.4426950408889634f;
  float pmax = p0[0];
#pragma unroll
  for (int r = 1; r < 16; ++r) pmax = fmaxf(pmax, p0[r]);
#pragma unroll
  for (int r = 0; r < 16; ++r) pmax = fmaxf(pmax, p1[r]);
  { auto rr = __builtin_amdgcn_permlane32_swap(__float_as_uint(pmax), __float_as_uint(pmax), false, false);
    pmax = fmaxf(__uint_as_float(rr[0]), __uint_as_float(rr[1])); }
  if (__builtin_expect(__all(pmax - m_reg <= THR / SCALE), 1)) { mn = m_reg; alpha = 1.f; }
  else { mn = fmaxf(m_reg, pmax); alpha = __builtin_amdgcn_exp2f((m_reg - mn) * C); m_reg = mn; }
  const float mnC = -mn * C;
#pragma unroll
  for (int r = 0; r < 16; ++r) p0[r] = fmaf(p0[r], C, mnC);
#pragma unroll
  for (int r = 0; r < 16; ++r) p1[r] = fmaf(p1[r], C, mnC);
#pragma unroll
  for (int r = 0; r < 16; ++r) p0[r] = __builtin_amdgcn_exp2f(p0[r]);
}
__device__ __forceinline__ void finishSM(f32x16& p0, f32x16& p1, float alpha, float& l_reg, bf16x8& pa0, bf16x8& pa1, bf16x8& pa2, bf16x8& pa3) {
#pragma unroll
  for (int r = 0; r < 16; ++r) p1[r] = __builtin_amdgcn_exp2f(p1[r]);
  float ps = 0;
#pragma unroll
  for (int r = 0; r < 16; ++r) ps += p0[r];
#pragma unroll
  for (int r = 0; r < 16; ++r) ps += p1[r];
  { auto rr = __builtin_amdgcn_permlane32_swap(__float_as_uint(ps), __float_as_uint(ps), false, false);
    ps = __uint_as_float(rr[0]) + __uint_as_float(rr[1]); }
  l_reg = l_reg * alpha + ps;
#define PK4(P, BASE, OUT) do { unsigned a0 = cvtpk(P[BASE + 0], P[BASE + 1]), a1 = cvtpk(P[BASE + 2], P[BASE + 3]);   \
    unsigned b0 = cvtpk(P[BASE + 4], P[BASE + 5]), b1 = cvtpk(P[BASE + 6], P[BASE + 7]);                              \
    auto r0 = __builtin_amdgcn_permlane32_swap(a0, b0, false, false); auto r1 = __builtin_amdgcn_permlane32_swap(a1, b1, false, false); \
    u32x4 w = {r0[0], r1[0], r0[1], r1[1]}; OUT = *reinterpret_cast<bf16x8*>(&w); } while (0)
  PK4(p0, 0, pa0); PK4(p0, 8, pa1); PK4(p1, 0, pa2); PK4(p1, 8, pa3);
#undef PK4
}
template <int NQD> __device__ __forceinline__ void qkt(f32x16& p0, f32x16& p1, const char* Ks, const bf16x8* qr, int kc0B, int r32, int hi) {
  p0 = f32x16{}; p1 = f32x16{};
#pragma unroll
  for (int d0 = 0; d0 < NQD; ++d0) { const int cb = kc0B + (d0 * 16 + hi * 8) * 2;
    const bf16x8 b0 = *reinterpret_cast<const bf16x8*>(Ks + KSWZ(r32, cb));
    const bf16x8 b1 = *reinterpret_cast<const bf16x8*>(Ks + KSWZ(32 + r32, cb));
    p0 = __builtin_amdgcn_mfma_f32_32x32x16_bf16(b0, qr[d0], p0, 0, 0, 0);
    p1 = __builtin_amdgcn_mfma_f32_32x32x16_bf16(b1, qr[d0], p1, 0, 0, 0); }
}
__device__ __forceinline__ int v_st(int k, int c) { const int kk = (k & ~0xC) | ((k & 4) << 1) | ((k & 8) >> 1); return ((kk >> 3) * 4 + (c >> 5)) * 512 + ((kk & 7) * 32 + (c & 31)) * 2; }
__device__ __forceinline__ int v_rd_base(int lane) { return ((lane & 3) << 3) | (((lane >> 2) & 3) << 6) | (((lane >> 4) & 1) << 5) | (((lane >> 5) & 1) << 8); }
constexpr int v_rd_off(int d0, int ks, int half) { return d0 * 512 + ks * 4096 + half * 2048; }
template <int OFF> __device__ __forceinline__ s16x4 tr_read(int vb) {
  s16x4 r; asm volatile("ds_read_b64_tr_b16 %0, %1 offset:%2" : "=&v"(r) : "v"(vb), "i"(OFF) : "memory"); return r;
}
template <int D0> __device__ __forceinline__ void pv_one(f32x16& od, int vb, bf16x8 pa0, bf16x8 pa1, bf16x8 pa2, bf16x8 pa3) {
  const s16x4 l0 = tr_read<v_rd_off(D0, 0, 0)>(vb), h0 = tr_read<v_rd_off(D0, 0, 1)>(vb), l1 = tr_read<v_rd_off(D0, 1, 0)>(vb), h1 = tr_read<v_rd_off(D0, 1, 1)>(vb);
  const s16x4 l2 = tr_read<v_rd_off(D0, 2, 0)>(vb), h2 = tr_read<v_rd_off(D0, 2, 1)>(vb), l3 = tr_read<v_rd_off(D0, 3, 0)>(vb), h3 = tr_read<v_rd_off(D0, 3, 1)>(vb);
  asm volatile("s_waitcnt lgkmcnt(0)" ::: "memory"); SBAR();
#define PK(L, H) (bf16x8){L[0], L[1], L[2], L[3], H[0], H[1], H[2], H[3]}
  od = __builtin_amdgcn_mfma_f32_32x32x16_bf16(pa0, PK(l0, h0), od, 0, 0, 0);
  od = __builtin_amdgcn_mfma_f32_32x32x16_bf16(pa1, PK(l1, h1), od, 0, 0, 0);
  od = __builtin_amdgcn_mfma_f32_32x32x16_bf16(pa2, PK(l2, h2), od, 0, 0, 0);
  od = __builtin_amdgcn_mfma_f32_32x32x16_bf16(pa3, PK(l3, h3), od, 0, 0, 0);
#undef PK
}
__device__ __forceinline__ void pv_d0(f32x16* o, int vb, bf16x8 pa0, bf16x8 pa1, bf16x8 pa2, bf16x8 pa3) {
  pv_one<0>(o[0], vb, pa0, pa1, pa2, pa3); pv_one<1>(o[1], vb, pa0, pa1, pa2, pa3); pv_one<2>(o[2], vb, pa0, pa1, pa2, pa3); pv_one<3>(o[3], vb, pa0, pa1, pa2, pa3);
}
__device__ __forceinline__ void wmask(f32x16& p0, f32x16& p1, int q, int kb, int hi) {
#pragma unroll
  for (int r = 0; r < 16; ++r) { const int d0 = kb + crow(r, hi) - q, d1 = d0 + 32;
    if (d0 > 128 || d0 < -128) p0[r] = -1e30f;
    if (d1 > 128 || d1 < -128) p1[r] = -1e30f; }
}

struct UnitArgs { const bf16* Q; const bf16* K; const bf16* V; bf16* O; int nkeys; int q0, k0; float m0, l0, lam, oscale; const float* subln; };
template <int MODE>
__device__ __forceinline__ void attn_unit(const UnitArgs& A, char* lds, const int wave_id) {
  constexpr int NQD = MODE == 0 ? 4 : 8;
  int tid_ = wave_id * 64 + lane_id(); asm volatile("" : "+v"(tid_));
  const int tid = tid_, wid = __builtin_amdgcn_readfirstlane(tid >> 6), lane = tid & 63, r32 = lane & 31, hi = lane >> 5;
  const int map = MODE == 0 ? (wid >> 2) : 0, wrow = MODE == 0 ? (wid & 3) * 32 : wid * 32;
  char* V_lds = lds; char* K_lds = lds + 2 * SHM_V;
  float* wsf = (float*)(lds + 2 * SHM_V + 2 * SHM_K) + wid * 64; float* li_l = wsf; float* al_l = wsf + 32;
  float m_reg = A.m0, l_reg = A.l0; f32x16 o[4] = {}; bf16x8 qr[NQD];
  const bf16* Qw = A.Q + (size_t)(wrow + r32) * NPROJ + map * 64 + hi * 8;
#pragma unroll
  for (int d0 = 0; d0 < NQD; ++d0) qr[d0] = *reinterpret_cast<const bf16x8*>(Qw + d0 * 16);
  const int kc0B = map * 128;
  const int sr = tid >> 4, sc = (tid & 15) * 8, vst0 = v_st(sr, sc), vst1 = v_st(32 + sr, sc);
  const int vb0 = (int)(uintptr_t)V_lds + v_rd_base(lane);
  const bf16* Kh = A.K; const bf16* Vh = A.V;
  struct { bf16x8 vs0, vs1, ks0, ks1; } sr_[2];
#define SLOAD(i, kk0) do { sr_[i].vs0 = *(const bf16x8*)(&Vh[(size_t)((kk0) + sr) * LDK + sc]); sr_[i].vs1 = *(const bf16x8*)(&Vh[(size_t)((kk0) + 32 + sr) * LDK + sc]); \
    sr_[i].ks0 = *(const bf16x8*)(&Kh[(size_t)((kk0) + sr) * LDK + sc]); sr_[i].ks1 = *(const bf16x8*)(&Kh[(size_t)((kk0) + 32 + sr) * LDK + sc]); } while (0)
#define SWRITE(b, i) do { *(bf16x8*)(V_lds + (b) * SHM_V + vst0) = sr_[i].vs0;          \
    *(bf16x8*)(V_lds + (b) * SHM_V + vst1) = sr_[i].vs1; const int kc = sc * 2;               \
    *(bf16x8*)(K_lds + (b) * SHM_K + KSWZ(sr, kc)) = sr_[i].ks0;                       \
    *(bf16x8*)(K_lds + (b) * SHM_K + KSWZ(32 + sr, kc)) = sr_[i].ks1; } while (0)
#define SWAIT() asm volatile("s_waitcnt vmcnt(4)" ::: "memory")
#define RESC(a) do { if (__any((a) < 1.f)) { if (hi == 0) al_l[r32] = (a); asm volatile("s_waitcnt lgkmcnt(0)" ::: "memory"); \
    _Pragma("unroll") for (int d = 0; d < 4; ++d) _Pragma("unroll") for (int r = 0; r < 16; ++r) o[d][r] *= al_l[crow(r, hi)]; } } while (0)
#define WMASK(P0, P1, j) do { if (MODE == 1) wmask(P0, P1, A.q0 + wrow + r32, A.k0 + (j) * KVBLK, hi); } while (0)
  f32x16 pA0, pA1, pB0, pB1; float mnA, mnB, alA, alB; bf16x8 pa0, pa1, pa2, pa3; const int NTL = A.nkeys / KVBLK;
  constexpr int SE = 0, SO = 1;
  SLOAD(SE, 0); asm volatile("s_waitcnt vmcnt(0)" ::: "memory"); SWRITE(0, SE); __syncthreads();
  qkt<NQD>(pA0, pA1, K_lds, qr, kc0B, r32, hi); WMASK(pA0, pA1, 0); partialSM<MODE>(pA0, pA1, m_reg, mnA, alA);
  SLOAD(SO, KVBLK); if (2 < NTL) SLOAD(SE, 2 * KVBLK);
  SWAIT(); SWRITE(1, SO); __syncthreads();
  for (int j = 1; j + 1 < NTL; j += 2) {
    SBAR(); qkt<NQD>(pB0, pB1, K_lds + SHM_K, qr, kc0B, r32, hi); WMASK(pB0, pB1, j);
    finishSM(pA0, pA1, alA, l_reg, pa0, pa1, pa2, pa3); SBAR();
    SLOAD(SO, (j + 2) * KVBLK); SBAR();
    pv_d0(o, vb0, pa0, pa1, pa2, pa3); partialSM<MODE>(pB0, pB1, m_reg, mnB, alB);
    __syncthreads(); SWAIT(); SWRITE(0, SE);
    RESC(alB); __syncthreads();
    SBAR(); qkt<NQD>(pA0, pA1, K_lds, qr, kc0B, r32, hi); WMASK(pA0, pA1, j + 1);
    finishSM(pB0, pB1, alB, l_reg, pa0, pa1, pa2, pa3); SBAR();
    if (j + 3 < NTL) SLOAD(SE, (j + 3) * KVBLK); SBAR();
    pv_d0(o, vb0 + SHM_V, pa0, pa1, pa2, pa3); partialSM<MODE>(pA0, pA1, m_reg, mnA, alA);
    __syncthreads(); SWAIT(); SWRITE(1, SO);
    RESC(alA); __syncthreads();
  }
  SBAR(); qkt<NQD>(pB0, pB1, K_lds + SHM_K, qr, kc0B, r32, hi); WMASK(pB0, pB1, NTL - 1);
  finishSM(pA0, pA1, alA, l_reg, pa0, pa1, pa2, pa3); SBAR();
  pv_d0(o, vb0, pa0, pa1, pa2, pa3); partialSM<MODE>(pB0, pB1, m_reg, mnB, alB);
  __syncthreads(); RESC(alB);
  finishSM(pB0, pB1, alB, l_reg, pa0, pa1, pa2, pa3); SBAR();
  pv_d0(o, vb0 + SHM_V, pa0, pa1, pa2, pa3);
  if (hi == 0) li_l[r32] = l_reg; asm volatile("s_waitcnt lgkmcnt(0)" ::: "memory");
  float rli[16];
#pragma unroll
  for (int r = 0; r < 16; ++r) rli[r] = __builtin_amdgcn_rcpf(li_l[crow(r, hi)]);
  if (MODE == 1) {
    bf16* Ow = A.O + (size_t)wrow * DM;
#pragma unroll
    for (int r = 0; r < 16; ++r) { const int orow = crow(r, hi);
#pragma unroll
      for (int d0 = 0; d0 < 4; ++d0) Ow[(size_t)orow * DM + d0 * 32 + r32] = (bf16)f2bf(o[d0][r] * rli[r]); }
  } else {
    __syncthreads();
    float* xch = (float*)lds + (wid & 3) * 4096;
    if (map == 1) {
#pragma unroll
      for (int d0 = 0; d0 < 4; ++d0)
#pragma unroll
        for (int r = 0; r < 16; ++r) xch[(d0 * 16 + r) * 64 + lane] = o[d0][r] * rli[r] * A.lam;
    }
    __syncthreads();
    if (map == 0) {
      float ss[16];
#pragma unroll
      for (int r = 0; r < 16; ++r) { float s = 0.f;
#pragma unroll
        for (int d0 = 0; d0 < 4; ++d0) { const float v = o[d0][r] * rli[r] - xch[(d0 * 16 + r) * 64 + lane]; o[d0][r] = v; s += v * v; }
        ss[r] = s; }
#pragma unroll
      for (int off = 1; off < 32; off <<= 1)
#pragma unroll
        for (int r = 0; r < 16; ++r) ss[r] += __shfl_xor(ss[r], off);
      float g4[4];
#pragma unroll
      for (int d0 = 0; d0 < 4; ++d0) g4[d0] = A.subln[d0 * 32 + r32] * A.oscale;
      bf16* Ow = A.O + (size_t)wrow * DM;
#pragma unroll
      for (int r = 0; r < 16; ++r) { const int orow = crow(r, hi); const float rs = rsqrtf(ss[r] * (1.f / 128.f) + EPS);
#pragma unroll
        for (int d0 = 0; d0 < 4; ++d0) Ow[(size_t)orow * DM + d0 * 32 + r32] = (bf16)f2bf(o[d0][r] * rs * g4[d0]); }
    }
    __syncthreads();
  }
#undef SLOAD
#undef SWRITE
#undef SWAIT
#undef RESC
#undef WMASK
}
#undef KSWZ
#undef SBAR
}

__device__ __forceinline__ float bf2f(unsigned short h) { return __builtin_bit_cast(float, (unsigned)h << 16); }
__device__ __forceinline__ float wave_sum(float v) {
#pragma unroll
    for (int o = 1; o < 64; o <<= 1) v += __shfl_xor(v, o);
    return v;
}
__device__ __forceinline__ float wave_max(float v) {
#pragma unroll
    for (int o = 1; o < 64; o <<= 1) v = fmaxf(v, __shfl_xor(v, o));
    return v;
}
__host__ __device__ __forceinline__ int inproj_dst_row(int n) {
    const int pn = n >> 8, r = n & 255;
    if (pn < 8) return (pn << 8) + 128 * ((r >> 5) & 1) + 32 * (r >> 6) + (r & 31);
    if (pn >= 12 && pn <= 16) return (pn << 8) + 128 * ((r >> 6) & 1) + 64 * (r >> 7) + (r & 63);
    return n;
}

struct Params { const float* in[15]; float* out; unsigned char* ws; };

__device__ __forceinline__ void p0_rope_tables(const int* __restrict__ pos, float* __restrict__ ra, float* __restrict__ rb, int gtid, int gthreads) {
    for (int idx = gtid; idx < NT * 96; idx += gthreads) {
        const int t = idx / 96, j = idx % 96;
        const int dim = j < 32 ? 64 : 128, i = j < 32 ? j : j - 32;
        const float inv = (float)pow(10000.0, -(double)(2 * i) / (double)dim);
        const float ang = (float)pos[t] * inv;
        double sn, cs; sincos((double)ang, &sn, &cs);
        float* dst = j < 32 ? ra + ((size_t)t * 32 + i) * 2 : rb + ((size_t)t * 64 + i) * 2;
        dst[0] = (float)cs; dst[1] = (float)sn;
    }
}
__device__ __forceinline__ void p0_mod_item(const float* __restrict__ ada_w, const float* __restrict__ ada_b, float* __restrict__ mod, int item, unsigned char* lds, int wave, int lane, int tid) {
    const f32x4* cact = (const f32x4*)lds; float* red = (float*)(lds + 32768);
    const int col = item * 128, l = col / NJ, j = col % NJ;
    typedef float f32x2 __attribute__((ext_vector_type(2)));
    const float* w = ada_w + (size_t)l * DM * NJ + j + 2 * lane;
    f32x2 a0 = {0.f, 0.f}, a1 = {0.f, 0.f}, a2 = {0.f, 0.f}, a3 = {0.f, 0.f};
    const int k0 = wave * 256;
#pragma unroll 8
    for (int k = k0; k < k0 + 256; ++k) { const f32x2 wv = *(const f32x2*)(w + (size_t)k * NJ); const f32x4 cv = cact[k];
        a0 += wv * cv[0]; a1 += wv * cv[1]; a2 += wv * cv[2]; a3 += wv * cv[3]; }
    float* rw = red + wave * 512;
    rw[0 * 64 + lane] = a0[0]; rw[1 * 64 + lane] = a0[1]; rw[2 * 64 + lane] = a1[0]; rw[3 * 64 + lane] = a1[1];
    rw[4 * 64 + lane] = a2[0]; rw[5 * 64 + lane] = a2[1]; rw[6 * 64 + lane] = a3[0]; rw[7 * 64 + lane] = a3[1];
    __syncthreads();
    {
        const int b = tid >> 7, cc = tid & 127; float s = 0.f;
#pragma unroll
        for (int wv = 0; wv < 8; ++wv) s += red[wv * 512 + (b * 2 + (cc & 1)) * 64 + (cc >> 1)];
        mod[((size_t)l * NB + b) * NJ + j + cc] = s + ada_b[(size_t)l * NJ + j + cc];
    }
    __syncthreads();
}
template <bool PERMUTE>
__device__ __forceinline__ void p0_wt_tile(const float* __restrict__ W, int K, int N, bf16* __restrict__ Wt, int kb, int nb, unsigned char* lds, int wave, int lane, int tid) {
    unsigned char* tl = lds + 65536;
    const int k0 = kb * 64 + wave * 8, n0 = nb * 256;
    float v[4][8];
#pragma unroll
    for (int kk = 0; kk < 8; ++kk)
#pragma unroll
        for (int e = 0; e < 4; ++e) v[e][kk] = W[(size_t)(k0 + kk) * N + n0 + lane + 64 * e];
#pragma unroll
    for (int e = 0; e < 4; ++e) { v4u o; o.x = pk2(v[e][0], v[e][1]); o.y = pk2(v[e][2], v[e][3]); o.z = pk2(v[e][4], v[e][5]); o.w = pk2(v[e][6], v[e][7]);
        *(v4u*)(tl + (lane + 64 * e) * 144 + wave * 16) = o; }
    __syncthreads();
#pragma unroll
    for (int i = 0; i < 4; ++i) { const int r = i * 64 + (tid >> 3), ch = tid & 7; const v4u o = *(const v4u*)(tl + r * 144 + ch * 16);
        const int dr = PERMUTE ? inproj_dst_row(n0 + r) : n0 + r;
        *(v4u*)(Wt + (size_t)dr * K + kb * 64 + ch * 8) = o; }
    __syncthreads();
}
__device__ __forceinline__ void norm_mod_row(const float* __restrict__ xrow, const float* __restrict__ g, const float* __restrict__ sh, const float* __restrict__ sc, bf16* __restrict__ hrow, int lane) {
    const f32x4* xr = (const f32x4*)xrow + lane;
    f32x4 v[8]; float s = 0.f;
#pragma unroll
    for (int j = 0; j < 8; ++j) { v[j] = xr[64 * j]; s += (v[j][0] * v[j][0] + v[j][1] * v[j][1]) + (v[j][2] * v[j][2] + v[j][3] * v[j][3]); }
    const float rstd = rsqrtf(wave_sum(s) * (1.f / DM) + EPS);
    unsigned long long* o8 = (unsigned long long*)hrow + lane;
#pragma unroll
    for (int j = 0; j < 8; ++j) { const f32x4 gv = ((const f32x4*)g)[lane + 64 * j], sv = ((const f32x4*)sc)[lane + 64 * j], hv = ((const f32x4*)sh)[lane + 64 * j];
        f32x4 y = (v[j] * rstd) * gv; y = y * (sv + 1.0f) + hv;
        o8[64 * j] = (unsigned long long)pk2(y[0], y[1]) | ((unsigned long long)pk2(y[2], y[3]) << 32); }
}
__device__ __forceinline__ void final_norm_row(const float* __restrict__ xrow, const float* __restrict__ g, float* __restrict__ orow, int lane) {
    const f32x4* xr = (const f32x4*)xrow + lane;
    f32x4 v[8]; float s = 0.f;
#pragma unroll
    for (int j = 0; j < 8; ++j) { v[j] = xr[64 * j]; s += (v[j][0] * v[j][0] + v[j][1] * v[j][1]) + (v[j][2] * v[j][2] + v[j][3] * v[j][3]); }
    const float rstd = rsqrtf(wave_sum(s) * (1.f / DM) + EPS);
#pragma unroll
    for (int j = 0; j < 8; ++j) ((f32x4*)orow)[lane + 64 * j] = (v[j] * rstd) * ((const f32x4*)g)[lane + 64 * j];
}

__global__ void __launch_bounds__(NTHREADS, 2) mega_fwd(Params p) {
    extern __shared__ __attribute__((aligned(16))) unsigned char lds_raw[];
    LAS unsigned char* lds = (LAS unsigned char*)lds_raw;
    const int tid = threadIdx.x, lane = tid & 63, wave = __builtin_amdgcn_readfirstlane(tid >> 6);
    const int G = gridDim.x, bid = blockIdx.x;
    const int gwave = bid * NWAVES + wave, NGW = G * NWAVES;
    unsigned char* ws = p.ws;
    gu32* ctl = (gu32*)(ws + WS_CTL);
    const float* x = p.in[0]; const float* c = p.in[1]; const int* pos = (const int*)p.in[2];
    const float* ada_w = p.in[3]; const float* ada_b = p.in[4]; const float* norm_mix = p.in[5];
    const float* w_in = p.in[6]; const float* diff_lambda = p.in[7]; const float* diff_subln = p.in[8];
    const float* swa_sink = p.in[9]; const float* w_out = p.in[10]; const float* norm_mlp = p.in[11];
    const float* w_up = p.in[12]; const float* w_down = p.in[13]; const float* final_norm = p.in[14];
    float* mod = (float*)(ws + WS_MOD); float* ra = (float*)(ws + WS_ROPEA); float* rb = (float*)(ws + WS_ROPEB);
    bf16* Win = (bf16*)(ws + WS_WIN); bf16* Wout = (bf16*)(ws + WS_WOUT); bf16* Wup = (bf16*)(ws + WS_WUP); bf16* Wdn = (bf16*)(ws + WS_WDN);
    float* X = (float*)(ws + WS_X); bf16* H = (bf16*)(ws + WS_H); bf16* PROJ = (bf16*)(ws + WS_PROJ); bf16* ATT = (bf16*)(ws + WS_ATT); bf16* U = (bf16*)(ws + WS_U);

    for (int u = tid; u < (LDS_BYTES - LDSCTL_OFF) / 4; u += NTHREADS) ((LAS unsigned*)(lds + LDSCTL_OFF))[u] = 0u;
    __syncthreads();
    (void)xcd_barrier_post((unsigned*)(ctl + CW_BAR), (volatile LAS unsigned*)(lds + MISC_OFF) + 8, tid == 0);
#define GRID_BAR() do { unsigned char* wsb_ = p.ws; asm volatile("" : "+s"(wsb_)); XcdBarrier b_; b_.bar = (unsigned*)(wsb_ + WS_CTL) + CW_BAR; b_.x = xb_xcc_id(); \
        b_.st = (volatile LAS unsigned*)(lds + MISC_OFF) + 8; xcd_barrier(b_, wave == 0 && lane_id() == 0); } while (0)
#define PHASE_LOCALS() int ln = lane_id(), gw = bid * NWAVES + wave; asm volatile("" : "+v"(ln)); asm volatile("" : "+s"(gw))

    {
        p0_rope_tables(pos, ra, rb, bid * NTHREADS + tid, G * NTHREADS);
        { float* cact = (float*)lds_raw; for (int i = tid; i < NB * DM; i += NTHREADS) { const float v = c[i]; cact[(i % DM) * 4 + i / DM] = v / (1.f + __expf(-v)); } }
        __syncthreads();
        constexpr int N_MOD_ITEMS = DEPTH * NJ / 128;
        for (int it = bid; it < N_MOD_ITEMS; it += G) p0_mod_item(ada_w, ada_b, mod, it, lds_raw, wave, lane, tid);
        constexpr int T_IN = 32 * 18, T_OUT = 32 * 8, T_UP = 32 * 32, T_DN = 128 * 8, T_L = T_IN + T_OUT + T_UP + T_DN, T_ALL = DEPTH * T_L;
        for (int it = bid; it < T_ALL; it += G) {
            const int l = it / T_L; int r = it % T_L;
            if (r < T_IN) { p0_wt_tile<true>(w_in + (size_t)l * DM * NPROJ, DM, NPROJ, Win + (size_t)l * NPROJ * DM, r / 18, r % 18, lds_raw, wave, lane, tid); continue; } r -= T_IN;
            if (r < T_OUT) { p0_wt_tile<false>(w_out + (size_t)l * DM * DM, DM, DM, Wout + (size_t)l * DM * DM, r / 8, r % 8, lds_raw, wave, lane, tid); continue; } r -= T_OUT;
            if (r < T_UP) { p0_wt_tile<false>(w_up + (size_t)l * DM * FF, DM, FF, Wup + (size_t)l * FF * DM, r / 32, r % 32, lds_raw, wave, lane, tid); continue; } r -= T_UP;
            p0_wt_tile<false>(w_down + (size_t)l * FF * DM, FF, DM, Wdn + (size_t)l * DM * FF, r / 8, r % 8, lds_raw, wave, lane, tid);
        }
    }
    cg::this_grid().sync();
    GRID_BAR();

    for (int l = 0; l < DEPTH; ++l) {
        const float* modl = mod + (size_t)l * NB * NJ;
        const float* xin = l == 0 ? x : X;
        const float lam_init = 0.8f - 0.6f * __expf(-0.3f * (float)l);
        { PHASE_LOCALS(); for (int m = gw; m < NT; m += NGW) { const int b = m / SEQ;
            norm_mod_row(xin + (size_t)m * DM, norm_mix + (size_t)l * DM, modl + (size_t)b * NJ + 0 * DM, modl + (size_t)b * NJ + 1 * DM, H + (size_t)m * DM, ln); } }
        GRID_BAR();
        { pg8::Gemm g{H, Win + (size_t)l * NPROJ * DM, NT, NPROJ, DM}; int c_ = bid; asm volatile("" : "+s"(c_)); pg8::StaticOrder S; S.init(NT, NPROJ, G, c_);
          pg8::EpiProj E{PROJ, ra, rb};
          pg8::gemm_phase<pg8::EpiProj, pg8::StaticOrder, true, true>(lds + RING_OFF, g, S, E, wave); }
        GRID_BAR();
        {
            PHASE_LOCALS();
            const float* lp = diff_lambda + (size_t)l * 256;
            const float lam = __expf(wave_sum(lp[ln] * lp[64 + ln])) - __expf(wave_sum(lp[128 + ln] * lp[192 + ln])) + lam_init;
            int vcu = (G % 8 == 0) ? (bid % 8) * (G / 8) + bid / 8 : bid; asm volatile("" : "+s"(vcu));
            for (int u = vcu; u < NB * 8 * 16; u += G) {
                const int bh = u >> 4, qb = u & 15, b = bh >> 3, h = bh & 7;
                att::UnitArgs A;
                A.Q = PROJ + (size_t)(b * SEQ + qb * 128) * NPROJ + h * 128; A.K = PROJ + (size_t)(b * SEQ) * NPROJ + 1024 + h * 128; A.V = PROJ + (size_t)(b * SEQ) * NPROJ + 2048 + h * 128;
                A.O = ATT + (size_t)(b * SEQ + qb * 128) * DM + h * 128; A.nkeys = SEQ; A.q0 = 0; A.k0 = 0; A.m0 = -1e30f; A.l0 = 0.f; A.lam = lam; A.oscale = 1.f - lam_init; A.subln = diff_subln + (size_t)l * HD;
                att::attn_unit<0>(A, (char*)lds_raw, wave);
            }
            for (int u = vcu; u < NB * 8 * 8; u += G) {
                const int bh = u >> 3, qb = u & 7, b = bh >> 3, h = bh & 7, g = h >> 2;
                const int q0 = qb * 256, ks = q0 - 128 < 0 ? 0 : q0 - 128, ke = q0 + 384 > SEQ ? SEQ : q0 + 384;
                att::UnitArgs A;
                A.Q = PROJ + (size_t)(b * SEQ + q0) * NPROJ + 3072 + h * 128; A.K = PROJ + (size_t)(b * SEQ + ks) * NPROJ + 4096 + g * 128; A.V = PROJ + (size_t)(b * SEQ + ks) * NPROJ + 4352 + g * 128;
                A.O = ATT + (size_t)(b * SEQ + q0) * DM + 1024 + h * 128; A.nkeys = ke - ks; A.q0 = q0; A.k0 = ks; A.m0 = swa_sink[(size_t)l * 8 + h] * 11.313708498984761f; A.l0 = 1.f; A.lam = 0.f; A.oscale = 1.f; A.subln = diff_subln;
                att::attn_unit<1>(A, (char*)lds_raw, wave);
            }
        }
        GRID_BAR();
        { pg8::Gemm g{ATT, Wout + (size_t)l * DM * DM, NT, DM, DM}; int c_ = bid; asm volatile("" : "+s"(c_)); pg8::StaticOrder S; S.init(NT, DM, G, c_);
          pg8::EpiRes E{xin, X, modl + 2 * DM};
          pg8::gemm_phase<pg8::EpiRes, pg8::StaticOrder, true, true>(lds + RING_OFF, g, S, E, wave); }
        GRID_BAR();
        { PHASE_LOCALS(); for (int m = gw; m < NT; m += NGW) { const int b = m / SEQ;
            norm_mod_row(X + (size_t)m * DM, norm_mlp + (size_t)l * DM, modl + (size_t)b * NJ + 3 * DM, modl + (size_t)b * NJ + 4 * DM, H + (size_t)m * DM, ln); } }
        GRID_BAR();
        { pg8::Gemm g{H, Wup + (size_t)l * FF * DM, NT, FF, DM}; int c_ = bid; asm volatile("" : "+s"(c_)); pg8::StaticOrder S; S.init(NT, FF, G, c_);
          pg8::EpiRelu2 E{U, FF, 0};
          pg8::gemm_phase<pg8::EpiRelu2, pg8::StaticOrder, true, true>(lds + RING_OFF, g, S, E, wave); }
        GRID_BAR();
        { pg8::Gemm g{U, Wdn + (size_t)l * DM * FF, NT, DM, FF}; int c_ = bid; asm volatile("" : "+s"(c_)); pg8::StaticOrder S; S.init(NT, DM, G, c_);
          pg8::EpiRes E{X, X, modl + 5 * DM};
          pg8::gemm_phase<pg8::EpiRes, pg8::StaticOrder, true, true>(lds + RING_OFF, g, S, E, wave); }
        GRID_BAR();
    }
    { PHASE_LOCALS(); for (int m = gw; m < NT; m += NGW) final_norm_row(X + (size_t)m * DM, final_norm, p.out + (size_t)m * DM, ln); }
}

extern "C" void kernel_launch(void* const* d_in, const int* in_sizes, int n_in, void* d_out, int out_size, void* d_ws, size_t ws_size, hipStream_t stream) {
    static int grid = 0;
    if (grid == 0) {
        if (n_in != 15 || out_size != NT * DM || ws_size < WS_END) { fprintf(stderr, "kernel_launch: unexpected shapes n_in %d out %d ws %zu (need %zu)\n", n_in, out_size, ws_size, (size_t)WS_END); grid = -1; return; }
        int dev = 0, cus = 0, per_cu = 0;
        if (hipGetDevice(&dev) != hipSuccess || hipDeviceGetAttribute(&cus, hipDeviceAttributeMultiprocessorCount, dev) != hipSuccess) { fprintf(stderr, "kernel_launch: device query failed\n"); grid = -1; return; }
        if (hipFuncSetAttribute((const void*)mega_fwd, hipFuncAttributeMaxDynamicSharedMemorySize, LDS_BYTES) != hipSuccess) { fprintf(stderr, "kernel_launch: hipFuncSetAttribute failed\n"); grid = -1; return; }
        if (hipOccupancyMaxActiveBlocksPerMultiprocessor(&per_cu, (const void*)mega_fwd, NTHREADS, LDS_BYTES) != hipSuccess || per_cu < 1) { fprintf(stderr, "kernel_launch: occupancy query says %d blocks per CU\n", per_cu); (void)hipGetLastError(); grid = -1; return; }
        grid = cus;
    }
    if (grid < 0) return;
    if (hipMemsetAsync((char*)d_ws + WS_CTL, 0, CTL_ZERO_BYTES, stream) != hipSuccess) { fprintf(stderr, "kernel_launch: memset failed\n"); return; }
    Params prm{};
    for (int i = 0; i < 15; ++i) prm.in[i] = (const float*)d_in[i];
    prm.out = (float*)d_out; prm.ws = (unsigned char*)d_ws;
    void* args[] = {&prm};
    hipError_t e = hipLaunchCooperativeKernel((const void*)mega_fwd, dim3(grid), dim3(NTHREADS), args, LDS_BYTES, stream);
    if (e != hipSuccess) fprintf(stderr, "kernel_launch: cooperative launch failed: %s (grid %d)\n", hipGetErrorString(e), grid);
}
```
